# Optimizing an MI355X kernel written in HIP

```python
import math
import jax, jax.numpy as jnp
from jax import lax
import numpy as np

D_MODEL = 2048
BATCH = 4
SEQ = 4096
DEPTH = 4

N_MIXERS = 2
N_POOL_LAYERS = (DEPTH + 1) // 2
N_MLA_LAYERS = DEPTH // 2
N_SUBLAYERS = 3
N_MOD = 3
D_FF = 5632
POOL_WINDOWS = (2, 4, 8, 16)
N_POOL_GROUPS = 4
POOL_GROUP_DIM = D_MODEL // N_POOL_GROUPS
MLA_HEADS = 16
Q_LORA_RANK = 512
KV_LORA_RANK = 512
QK_NOPE_DIM = 128
QK_ROPE_DIM = 64
V_HEAD_DIM = 128
QK_HEAD_DIM = QK_NOPE_DIM + QK_ROPE_DIM
ROPE_THETA = 10000.0
Q_BLOCK = 128
NORM_EPS = 1e-6
ADA_INIT = 0.1

kernel_name = "hybrid_pool_mla_macaron_adaln"


def _rms_norm(x, g):
    xf = x.astype(jnp.float32)
    y = xf * lax.rsqrt(jnp.mean(xf * xf, axis=-1, keepdims=True) + NORM_EPS)
    return (y * g.astype(jnp.float32)).astype(x.dtype)


def _swiglu(h, w_gate, w_up, w_down):
    return (jax.nn.silu(h @ w_gate) * (h @ w_up)) @ w_down


def _rope(x, cos, sin):
    x1, x2 = jnp.split(x, 2, axis=-1)
    return jnp.concatenate([x1 * cos - x2 * sin, x2 * cos + x1 * sin], axis=-1)


def _sublayer(x, mod_s, g_pre, g_post, fn, weight):
    shift = mod_s[:, 0, None, :]
    scale = mod_s[:, 1, None, :]
    gate = mod_s[:, 2, None, :]
    h = _rms_norm(x, g_pre) * (1.0 + scale) + shift
    y = _rms_norm(fn(h), g_post)
    return x + weight * (1.0 + gate) * y


def _pool_mixer(h, w_group, b_group, ch_scale):
    s = h.shape[1]
    hf = h.astype(jnp.float32)
    t = jnp.arange(s)
    outs = []
    for g, w in enumerate(POOL_WINDOWS):
        hg = hf[..., g * POOL_GROUP_DIM:(g + 1) * POOL_GROUP_DIM]
        cs = jnp.cumsum(hg, axis=1)
        cs_lag = jnp.pad(cs, ((0, 0), (w, 0), (0, 0)))[:, :s]
        count = jnp.minimum(t + 1, w).astype(jnp.float32)
        pooled = (cs - cs_lag) / count[None, :, None] - hg
        outs.append(pooled.astype(h.dtype) @ w_group[g] + b_group[g])
    return jnp.concatenate(outs, axis=-1) * ch_scale


def _mla(h, positions, w_dq, q_norm, w_uq, w_dkv, kv_norm, w_ukv, w_o):
    b, s, _ = h.shape
    inv_freq = ROPE_THETA ** (-jnp.arange(0, QK_ROPE_DIM, 2, dtype=jnp.float32) / QK_ROPE_DIM)
    ang = positions.astype(jnp.float32)[..., None] * inv_freq
    cos = jnp.cos(ang).astype(h.dtype)
    sin = jnp.sin(ang).astype(h.dtype)
    c_q = _rms_norm(h @ w_dq, q_norm)
    q = (c_q @ w_uq).reshape(b, s, MLA_HEADS, QK_HEAD_DIM)
    q_nope = q[..., :QK_NOPE_DIM]
    q_rope = _rope(q[..., QK_NOPE_DIM:], cos[:, :, None, :], sin[:, :, None, :])
    ckv = h @ w_dkv
    c_kv = _rms_norm(ckv[..., :KV_LORA_RANK], kv_norm)
    k_rope = _rope(ckv[..., KV_LORA_RANK:], cos, sin)
    kv = (c_kv @ w_ukv).reshape(b, s, MLA_HEADS, QK_NOPE_DIM + V_HEAD_DIM)
    k_nope = kv[..., :QK_NOPE_DIM]
    v = kv[..., QK_NOPE_DIM:]
    sm_scale = QK_HEAD_DIM ** -0.5
    neg = jnp.finfo(jnp.float32).min
    outs = []
    for i in range(s // Q_BLOCK):
        qs, qe = i * Q_BLOCK, (i + 1) * Q_BLOCK
        sc = jnp.einsum('bqhd,bkhd->bhqk', q_nope[:, qs:qe], k_nope[:, :qe],
                        preferred_element_type=jnp.float32)
        sc = sc + jnp.einsum('bqhr,bkr->bhqk', q_rope[:, qs:qe], k_rope[:, :qe],
                             preferred_element_type=jnp.float32)
        causal = jnp.arange(qs, qe)[:, None] >= jnp.arange(qe)[None, :]
        sc = jnp.where(causal[None, None], sc * sm_scale, neg)
        p = jax.nn.softmax(sc, axis=-1)
        outs.append(jnp.einsum('bhqk,bkhd->bqhd', p.astype(v.dtype), v[:, :qe]))
    o = jnp.concatenate(outs, axis=1).reshape(b, s, MLA_HEADS * V_HEAD_DIM)
    return o @ w_o


def setup_inputs(seed: int = 0) -> dict:
    key = jax.random.key(seed)
    ks = jax.random.split(key, 24)
    f32 = jnp.float32

    def nrm(k, shape, fan_in, mult=1.0):
        return jax.random.normal(k, shape, f32) * (mult * fan_in ** -0.5)

    def gain(k, shape, s=0.05):
        return 1.0 + s * jax.random.normal(k, shape, f32)

    def small(k, shape):
        return 0.01 * jax.random.normal(k, shape, f32)

    n_mod = N_SUBLAYERS * N_MOD * D_MODEL
    return {
        "x": jax.random.normal(ks[0], (BATCH, SEQ, D_MODEL), f32),
        "c": jax.random.normal(ks[1], (BATCH, D_MODEL), f32),
        "positions": jnp.tile(jnp.arange(SEQ, dtype=jnp.int32)[None, :], (BATCH, 1)),
        "ada_w": nrm(ks[2], (DEPTH, D_MODEL, n_mod), D_MODEL, ADA_INIT),
        "ada_b": small(ks[3], (DEPTH, n_mod)),
        "norm_pre": gain(ks[4], (DEPTH, N_SUBLAYERS, D_MODEL)),
        "norm_post": gain(ks[5], (DEPTH, N_SUBLAYERS, D_MODEL)),
        "ffn_w_gate": nrm(ks[6], (DEPTH, 2, D_MODEL, D_FF), D_MODEL),
        "ffn_w_up": nrm(ks[7], (DEPTH, 2, D_MODEL, D_FF), D_MODEL),
        "ffn_w_down": nrm(ks[8], (DEPTH, 2, D_FF, D_MODEL), D_FF),
        "pool_w": nrm(ks[9], (N_POOL_LAYERS, N_POOL_GROUPS, POOL_GROUP_DIM, POOL_GROUP_DIM), POOL_GROUP_DIM),
        "pool_b": small(ks[10], (N_POOL_LAYERS, N_POOL_GROUPS, POOL_GROUP_DIM)),
        "pool_scale": gain(ks[11], (N_POOL_LAYERS, D_MODEL), 0.1),
        "mla_w_dq": nrm(ks[12], (N_MLA_LAYERS, D_MODEL, Q_LORA_RANK), D_MODEL),
        "mla_q_norm": gain(ks[13], (N_MLA_LAYERS, Q_LORA_RANK)),
        "mla_w_uq": nrm(ks[14], (N_MLA_LAYERS, Q_LORA_RANK, MLA_HEADS * QK_HEAD_DIM), Q_LORA_RANK),
        "mla_w_dkv": nrm(ks[15], (N_MLA_LAYERS, D_MODEL, KV_LORA_RANK + QK_ROPE_DIM), D_MODEL),
        "mla_kv_norm": gain(ks[16], (N_MLA_LAYERS, KV_LORA_RANK)),
        "mla_w_ukv": nrm(ks[17], (N_MLA_LAYERS, KV_LORA_RANK, MLA_HEADS * (QK_NOPE_DIM + V_HEAD_DIM)), KV_LORA_RANK),
        "mla_w_o": nrm(ks[18], (N_MLA_LAYERS, MLA_HEADS * V_HEAD_DIM, D_MODEL), MLA_HEADS * V_HEAD_DIM),
    }


def reference(x, c, positions, ada_w, ada_b, norm_pre, norm_post, ffn_w_gate, ffn_w_up,
              ffn_w_down, pool_w, pool_b, pool_scale, mla_w_dq, mla_q_norm, mla_w_uq,
              mla_w_dkv, mla_kv_norm, mla_w_ukv, mla_w_o):
    b = x.shape[0]
    c_act = jax.nn.silu(c)
    for layer in range(DEPTH):
        mod = (c_act @ ada_w[layer] + ada_b[layer]).reshape(b, N_SUBLAYERS, N_MOD, D_MODEL)
        x = _sublayer(x, mod[:, 0], norm_pre[layer, 0], norm_post[layer, 0],
                      lambda h: _swiglu(h, ffn_w_gate[layer, 0], ffn_w_up[layer, 0], ffn_w_down[layer, 0]),
                      0.5)
        j = layer // N_MIXERS
        if layer % N_MIXERS == 0:
            mixer = lambda h: _pool_mixer(h, pool_w[j], pool_b[j], pool_scale[j])
        else:
            mixer = lambda h: _mla(h, positions, mla_w_dq[j], mla_q_norm[j], mla_w_uq[j],
                                   mla_w_dkv[j], mla_kv_norm[j], mla_w_ukv[j], mla_w_o[j])
        x = _sublayer(x, mod[:, 1], norm_pre[layer, 1], norm_post[layer, 1], mixer, 1.0)
        x = _sublayer(x, mod[:, 2], norm_pre[layer, 2], norm_post[layer, 2],
                      lambda h: _swiglu(h, ffn_w_gate[layer, 1], ffn_w_up[layer, 1], ffn_w_down[layer, 1]),
                      0.5)
    return x
```

```cpp
#include <hip/hip_runtime.h>
#include <cstdio>
#include <cstdint>

#ifndef NLP
#define NLP (DEPTH / 2)
#endif
#ifndef MK_ONE_LAUNCH
#define MK_ONE_LAUNCH 0
#endif

namespace pg8 {
#define PG8_LAS __attribute__((address_space(3)))
typedef unsigned short bf16_t;
typedef short bf16x8 __attribute__((ext_vector_type(8)));
typedef float f32x4 __attribute__((ext_vector_type(4)));
typedef unsigned u32x4 __attribute__((ext_vector_type(4)));
constexpr int BM = 256, BK = 64, HALF = 128, HTB = HALF * BK * 2, STAGE_BYTES = 8 * HTB, NXCD = 8, WGM = 8;

__host__ __device__ __forceinline__ int lds_byte(int r, int c) { const int st = (r >> 4) * 2 + (c >> 5), rr = r & 15, cc = c & 31, ob = rr * 64 + cc * 2; return st * 1024 + (ob ^ (((ob >> 9) & 1) << 5)); }
__host__ __device__ __forceinline__ void stage_rc(int b, int& R, int& C) { const int st = b / 1024, sb = b % 1024, swz = sb ^ (((sb >> 9) & 1) << 5); R = (st >> 1) * 16 + swz / 64; C = (st & 1) * 32 + (swz % 64) / 2; }
__host__ __device__ __forceinline__ int perm32(int rho) { const int n = rho >> 4, i = rho & 15; return 8 * (i >> 2) + 4 * n + (i & 3); }

struct Unit { int pm, pn; };
struct Gemm { const bf16_t* A; const bf16_t* Bt; int M, N, K, lda, ldb, ashift, astep; };

struct StaticOrder {
    int nM, nN, nwg, G, c;
    __host__ __device__ void init(int M, int N, int G_, int c_) { nM = M / BM; nN = N / BM; nwg = nM * nN; G = G_; c = c_; }
    __host__ __device__ bool next(int i, Unit& u) const {
        const long L = (long)i * G + c; if (L >= nwg) return false;
        int wgid = (int)L; { const int q = nwg / NXCD, r = nwg % NXCD, xcd = wgid % NXCD, off = wgid / NXCD; wgid = (xcd < r ? xcd * (q + 1) : r * (q + 1) + (xcd - r) * q) + off; }
        const int nig = WGM * nN, gid = wgid / nig, fm = gid * WGM, gsz = (nM - fm) < WGM ? (nM - fm) : WGM;
        u.pm = fm + ((wgid % nig) % gsz); u.pn = (wgid % nig) / gsz; return true;
    }
    __device__ __forceinline__ void a_ready(const Unit&) const {}
    __device__ __forceinline__ void done(const Unit&) const {}
};

__device__ __forceinline__ unsigned cvt_pk_bf16(float lo, float hi) { unsigned r; asm volatile("v_cvt_pk_bf16_f32 %0, %1, %2" : "=v"(r) : "v"(lo), "v"(hi)); return r; }

__device__ __forceinline__ float silu_mul(float g, float u) { return g * __builtin_amdgcn_rcpf(1.0f + __builtin_amdgcn_exp2f(-1.4426950408889634f * g)) * u; }

struct EpiSwiGLU {
    static constexpr bool PERM = true, AFTER_DRAIN = false;
    bf16_t* O; int ldc;
    __device__ __forceinline__ void operator()(const f32x4 (&acc)[2][2][4][2], const Unit& u, int wr, int wc, int fr, int fq) const {
        const int row0 = u.pm * BM + wr * 64 + fr, col0 = u.pn * HALF + wc * 32 + 8 * fq;
#pragma unroll
        for (int ai = 0; ai < 2; ++ai)
#pragma unroll
            for (int m = 0; m < 4; ++m) { bf16_t* rowp = O + (size_t)(row0 + ai * HALF + m * 16) * ldc + col0;
                const f32x4 g0 = acc[ai][0][m][0], g1 = acc[ai][0][m][1], u0 = acc[ai][1][m][0], u1 = acc[ai][1][m][1];
                u32x4 w; w.x = cvt_pk_bf16(silu_mul(g0[0], u0[0]), silu_mul(g0[1], u0[1])); w.y = cvt_pk_bf16(silu_mul(g0[2], u0[2]), silu_mul(g0[3], u0[3]));
                w.z = cvt_pk_bf16(silu_mul(g1[0], u1[0]), silu_mul(g1[1], u1[1])); w.w = cvt_pk_bf16(silu_mul(g1[2], u1[2]), silu_mul(g1[3], u1[3]));
                *(u32x4*)rowp = w; }
    }
};
struct EpiBf16G {
    static constexpr bool PERM = true, AFTER_DRAIN = false;
    bf16_t* O; int ldc, bjstride; const float* bias; const float* scale;
    __device__ __forceinline__ void operator()(const f32x4 (&acc)[2][2][4][2], const Unit& u, int wr, int wc, int fr, int fq) const {
        const int row0 = u.pm * BM + wr * 64 + fr, cc = wc * 32 + 8 * fq;
        f32x4 bv[2][2], sv[2][2];
#pragma unroll
        for (int bj = 0; bj < 2; ++bj)
#pragma unroll
            for (int n = 0; n < 2; ++n) { const int c = u.pn * BM + bj * HALF + cc + 4 * n;
                bv[bj][n] = bias ? *(const f32x4*)(bias + c) : (f32x4){0.f, 0.f, 0.f, 0.f}; sv[bj][n] = scale ? *(const f32x4*)(scale + c) : (f32x4){1.f, 1.f, 1.f, 1.f}; }
#pragma unroll
        for (int ai = 0; ai < 2; ++ai)
#pragma unroll
            for (int m = 0; m < 4; ++m) { bf16_t* rowp = O + (size_t)(row0 + ai * HALF + m * 16) * ldc + cc;
#pragma unroll
                for (int bj = 0; bj < 2; ++bj) { const f32x4 v0 = (acc[ai][bj][m][0] + bv[bj][0]) * sv[bj][0], v1 = (acc[ai][bj][m][1] + bv[bj][1]) * sv[bj][1];
                    u32x4 w; w.x = cvt_pk_bf16(v0[0], v0[1]); w.y = cvt_pk_bf16(v0[2], v0[3]); w.z = cvt_pk_bf16(v1[0], v1[1]); w.w = cvt_pk_bf16(v1[2], v1[3]);
                    *(u32x4*)(rowp + (size_t)(u.pn * 2 + bj) * bjstride) = w; } }
    }
};
struct EpiF32 {
    static constexpr bool PERM = false, AFTER_DRAIN = false;
    float* C; int ldc;
    __device__ __forceinline__ void operator()(const f32x4 (&acc)[2][2][4][2], const Unit& u, int wr, int wc, int fr, int fq) const {
        const int row0 = u.pm * BM + wr * 64 + fr, col0 = u.pn * BM + wc * 32 + 4 * fq;
#pragma unroll
        for (int ai = 0; ai < 2; ++ai)
#pragma unroll
            for (int m = 0; m < 4; ++m) { float* rowp = C + (size_t)(row0 + ai * HALF + m * 16) * ldc + col0;
#pragma unroll
                for (int bj = 0; bj < 2; ++bj)
#pragma unroll
                    for (int n = 0; n < 2; ++n) *(f32x4*)(rowp + bj * HALF + n * 16) = acc[ai][bj][m][n]; }
    }
};
struct EpiQ {
    static constexpr bool PERM = true, AFTER_DRAIN = false;
    bf16_t* O; const float* cosT; const float* sinT; float qscale;
    __device__ __forceinline__ void operator()(const f32x4 (&acc)[2][2][4][2], const Unit& u, int wr, int wc, int fr, int fq) const {
        const int row0 = u.pm * BM + wr * 64 + fr;
#pragma unroll
        for (int bj = 0; bj < 2; ++bj) {
            const int c0 = u.pn * BM + bj * HALF + wc * 32 + 8 * fq; const int hd = c0 / 192, d = c0 - hd * 192; const bool rope = d >= 128; const int i0 = rope ? ((d - 128) >> 1) : 0;
#pragma unroll
            for (int ai = 0; ai < 2; ++ai)
#pragma unroll
                for (int m = 0; m < 4; ++m) { const int row = row0 + ai * HALF + m * 16;
                    f32x4 v0 = acc[ai][bj][m][0], v1 = acc[ai][bj][m][1];
                    if (rope) { const f32x4 cs = *(const f32x4*)(cosT + (size_t)row * 32 + i0), sn = *(const f32x4*)(sinT + (size_t)row * 32 + i0);
                        const f32x4 a = v0, b = v1;
                        v0[0] = a[0] * cs[0] - a[1] * sn[0]; v0[1] = a[1] * cs[0] + a[0] * sn[0]; v0[2] = a[2] * cs[1] - a[3] * sn[1]; v0[3] = a[3] * cs[1] + a[2] * sn[1];
                        v1[0] = b[0] * cs[2] - b[1] * sn[2]; v1[1] = b[1] * cs[2] + b[0] * sn[2]; v1[2] = b[2] * cs[3] - b[3] * sn[3]; v1[3] = b[3] * cs[3] + b[2] * sn[3]; }
                    v0 = v0 * qscale; v1 = v1 * qscale;
                    u32x4 w; w.x = cvt_pk_bf16(v0[0], v0[1]); w.y = cvt_pk_bf16(v0[2], v0[3]); w.z = cvt_pk_bf16(v1[0], v1[1]); w.w = cvt_pk_bf16(v1[2], v1[3]);
                    *(u32x4*)(O + (size_t)row * 3072 + c0) = w; }
        }
    }
};

template <class Epi, class Sched, bool ALIGN_EPI = false, bool SP2 = false>
__device__ __forceinline__ void gemm_phase(PG8_LAS unsigned char* lds, const Gemm g, const Sched& S, const Epi& E, const int tid) {
    const int wid = __builtin_amdgcn_readfirstlane(tid >> 6), lane = tid & 63, wr = wid >> 2, wc = wid & 3, fr = lane & 15, fq = lane >> 4;
    const int K = g.K, nt = K / BK;
    unsigned voffA[2], voffB[2];
#pragma unroll
    for (int i = 0; i < 2; ++i) { int R, C; stage_rc(tid * 16 + i * 8192, R, C); const int Rb = Epi::PERM ? ((R & ~31) + perm32(R & 31)) : R;
        voffA[i] = (unsigned)(R * g.lda + C) * 2u; voffB[i] = (unsigned)(Rb * g.ldb + C) * 2u; }
    const size_t kstep = (size_t)(BK * 2);
    const size_t hsA = (size_t)HALF * g.lda * 2, hsB = (size_t)HALF * g.ldb * 2;
    const unsigned ldsw = (unsigned)wid * 1024u;
    const int aoff = lds_byte(wr * 64 + fr, fq * 8), boff = lds_byte(wc * 32 + fr, fq * 8);
#define PG8_SA(b, h) (((b) * 2 + (h)) * HTB)
#define PG8_SB(b, h) ((4 + (b) * 2 + (h)) * HTB)
#define PG8_STAGE(bufoff, gbase, voff) do { _Pragma("unroll") for (int _i = 0; _i < 2; ++_i) \
        __builtin_amdgcn_global_load_lds((const unsigned*)((const char*)(gbase) + (voff)[_i]), (PG8_LAS unsigned*)(lds + (bufoff) + ldsw + _i * 8192), 16, 0, 0); } while (0)
#define PG8_LDA(dst, b, h) do { _Pragma("unroll") for (int m = 0; m < 4; ++m) _Pragma("unroll") for (int k = 0; k < 2; ++k) dst[m][k] = *(const PG8_LAS bf16x8*)(lds + PG8_SA(b, h) + aoff + m * 2048 + k * 1024); } while (0)
#define PG8_LDB(dst, b, h) do { _Pragma("unroll") for (int n = 0; n < 2; ++n) _Pragma("unroll") for (int k = 0; k < 2; ++k) dst[n][k] = *(const PG8_LAS bf16x8*)(lds + PG8_SB(b, h) + boff + n * 2048 + k * 1024); } while (0)
#define PG8_MMA(ai, bj, At, Bt) do { __builtin_amdgcn_s_setprio(1); _Pragma("unroll") for (int m = 0; m < 4; ++m) _Pragma("unroll") for (int n = 0; n < 2; ++n) _Pragma("unroll") for (int k = 0; k < 2; ++k) \
        acc[ai][bj][m][n] = __builtin_amdgcn_mfma_f32_16x16x32_bf16(Bt[n][k], At[m][k], acc[ai][bj][m][n], 0, 0, 0); __builtin_amdgcn_s_setprio(0); } while (0)
#define PG8_WAIT_V(n) asm volatile("s_waitcnt vmcnt(" #n ")" ::: "memory")
#define PG8_WAIT_L(n) asm volatile("s_waitcnt lgkmcnt(" #n ")" ::: "memory")
#define PG8_BAR __builtin_amdgcn_s_barrier()
#define PG8_SCHED __builtin_amdgcn_sched_barrier(0)
    Unit cur, nxt; int ui = 0;
    if (!S.next(0, cur)) return;
    f32x4 acc[2][2][4][2];
#pragma unroll
    for (int a = 0; a < 2; ++a)
#pragma unroll
        for (int b = 0; b < 2; ++b)
#pragma unroll
            for (int m = 0; m < 4; ++m)
#pragma unroll
                for (int n = 0; n < 2; ++n) acc[a][b][m][n] = (f32x4){0.f, 0.f, 0.f, 0.f};
    bf16x8 At[4][2], B0[2][2], B1[2][2];
    const char* cA = (const char*)g.A + (size_t)cur.pm * 2 * hsA + (size_t)((cur.pn >> g.ashift) * g.astep) * 2; const char* cB = (const char*)g.Bt + (size_t)cur.pn * 2 * hsB;
    S.a_ready(cur);
    if constexpr (SP2) {
        PG8_STAGE(PG8_SB(0, 0), cB, voffB); PG8_STAGE(PG8_SB(0, 1), cB + hsB, voffB); PG8_STAGE(PG8_SA(0, 0), cA, voffA); PG8_STAGE(PG8_SA(0, 1), cA + hsA, voffA);
        if (wr == 1) PG8_BAR;
        PG8_WAIT_V(2); PG8_BAR;
        PG8_STAGE(PG8_SB(1, 0), cB + kstep, voffB); PG8_STAGE(PG8_SA(1, 0), cA + kstep, voffA); PG8_STAGE(PG8_SB(1, 1), cB + hsB + kstep, voffB);
        PG8_WAIT_V(6); PG8_BAR;
    } else {
        PG8_STAGE(PG8_SB(0, 0), cB, voffB); PG8_STAGE(PG8_SA(0, 0), cA, voffA); PG8_STAGE(PG8_SB(0, 1), cB + hsB, voffB); PG8_STAGE(PG8_SA(0, 1), cA + hsA, voffA);
        if (wr == 1) PG8_BAR;
        PG8_WAIT_V(4); PG8_BAR;
        PG8_STAGE(PG8_SB(1, 0), cB + kstep, voffB); PG8_STAGE(PG8_SA(1, 0), cA + kstep, voffA); PG8_STAGE(PG8_SB(1, 1), cB + hsB + kstep, voffB);
        PG8_WAIT_V(6); PG8_BAR;
    }
    for (;;) {
        const bool has_next = S.next(ui + 1, nxt);
        const char* nA = has_next ? (const char*)g.A + (size_t)nxt.pm * 2 * hsA + (size_t)((nxt.pn >> g.ashift) * g.astep) * 2 : cA; const char* nB = has_next ? (const char*)g.Bt + (size_t)nxt.pn * 2 * hsB : cB;
        for (int t = 0; t < nt; t += 2) {
            const bool last = (t == nt - 2);
            const char* a1 = cA + (size_t)(t + 1) * kstep;
            const char* a2 = last ? nA : cA + (size_t)(t + 2) * kstep; const char* b2 = last ? nB : cB + (size_t)(t + 2) * kstep;
            const char* a3 = a2 + kstep; const char* b3 = b2 + kstep;
            if (last && has_next) S.a_ready(nxt);
            if constexpr (SP2) {
            PG8_LDB(B0, 0, 0); PG8_LDB(B1, 0, 1); PG8_SCHED; PG8_LDA(At, 0, 0); PG8_STAGE(PG8_SA(1, 1), a1 + hsA, voffA);
            PG8_WAIT_V(8); PG8_WAIT_L(0); PG8_BAR; PG8_MMA(0, 0, At, B0); PG8_MMA(0, 1, At, B1); PG8_BAR; PG8_SCHED;
            PG8_LDA(At, 0, 1); PG8_STAGE(PG8_SB(0, 0), b2, voffB); PG8_STAGE(PG8_SB(0, 1), b2 + hsB, voffB); PG8_STAGE(PG8_SA(0, 0), a2, voffA);
            PG8_WAIT_V(8); PG8_WAIT_L(0); PG8_BAR; PG8_MMA(1, 0, At, B0); PG8_MMA(1, 1, At, B1); PG8_BAR; PG8_SCHED;
            PG8_LDB(B0, 1, 0); PG8_LDB(B1, 1, 1); PG8_SCHED; PG8_LDA(At, 1, 0); PG8_STAGE(PG8_SA(0, 1), a2 + hsA, voffA);
            PG8_WAIT_V(8); PG8_WAIT_L(0); PG8_BAR; PG8_MMA(0, 0, At, B0); PG8_MMA(0, 1, At, B1); PG8_BAR; PG8_SCHED;
            PG8_LDA(At, 1, 1); PG8_STAGE(PG8_SB(1, 0), b3, voffB); PG8_STAGE(PG8_SB(1, 1), b3 + hsB, voffB); PG8_STAGE(PG8_SA(1, 0), a3, voffA);
            PG8_WAIT_V(8); PG8_WAIT_L(0); PG8_BAR; PG8_MMA(1, 0, At, B0); PG8_MMA(1, 1, At, B1); PG8_BAR; PG8_SCHED;
            } else {
            PG8_LDB(B0, 0, 0); PG8_SCHED; PG8_LDA(At, 0, 0); PG8_STAGE(PG8_SA(1, 1), a1 + hsA, voffA);
            PG8_WAIT_L(8); PG8_BAR; PG8_WAIT_L(0); PG8_MMA(0, 0, At, B0); PG8_BAR; PG8_SCHED;
            PG8_LDB(B1, 0, 1); PG8_STAGE(PG8_SB(0, 0), b2, voffB);
            PG8_BAR; PG8_WAIT_L(0); PG8_MMA(0, 1, At, B1); PG8_BAR;
            PG8_LDA(At, 0, 1); PG8_STAGE(PG8_SA(0, 0), a2, voffA);
            PG8_BAR; PG8_WAIT_L(0); PG8_MMA(1, 0, At, B0); PG8_BAR; PG8_SCHED;
            PG8_STAGE(PG8_SB(0, 1), b2 + hsB, voffB);
            PG8_WAIT_V(6); PG8_BAR; PG8_MMA(1, 1, At, B1); PG8_BAR;
            PG8_LDB(B0, 1, 0); PG8_SCHED; PG8_LDA(At, 1, 0); PG8_STAGE(PG8_SA(0, 1), a2 + hsA, voffA);
            PG8_WAIT_L(8); PG8_BAR; PG8_WAIT_L(0); PG8_MMA(0, 0, At, B0); PG8_BAR; PG8_SCHED;
            PG8_LDB(B1, 1, 1); PG8_STAGE(PG8_SB(1, 0), b3, voffB);
            PG8_BAR; PG8_WAIT_L(0); PG8_MMA(0, 1, At, B1); PG8_BAR;
            PG8_LDA(At, 1, 1); PG8_STAGE(PG8_SA(1, 0), a3, voffA);
            PG8_BAR; PG8_WAIT_L(0); PG8_MMA(1, 0, At, B0); PG8_BAR; PG8_SCHED;
            PG8_STAGE(PG8_SB(1, 1), b3 + hsB, voffB);
            PG8_WAIT_V(6); PG8_BAR; PG8_MMA(1, 1, At, B1); PG8_BAR;
            }
        }
        if constexpr (ALIGN_EPI) { if (wr == 0) PG8_BAR; }
        E(acc, cur, wr, wc, fr, fq); S.done(cur);
        if (!has_next) break;
#pragma unroll
        for (int a = 0; a < 2; ++a)
#pragma unroll
            for (int b = 0; b < 2; ++b)
#pragma unroll
                for (int m = 0; m < 4; ++m)
#pragma unroll
                    for (int n = 0; n < 2; ++n) acc[a][b][m][n] = (f32x4){0.f, 0.f, 0.f, 0.f};
        cur = nxt; cA = nA; cB = nB; ++ui;
        if constexpr (ALIGN_EPI) { if (wr == 1) PG8_BAR; }
    }
    PG8_WAIT_V(0);
    if constexpr (!ALIGN_EPI) { if (wr == 0) PG8_BAR; }
    PG8_BAR;
#undef PG8_SA
#undef PG8_SB
#undef PG8_STAGE
#undef PG8_LDA
#undef PG8_LDB
#undef PG8_MMA
#undef PG8_WAIT_V
#undef PG8_WAIT_L
#undef PG8_BAR
#undef PG8_SCHED
}
}

constexpr int NWAVES = 8;
constexpr int BATCH = 4, SEQ = 4096, D = 2048, M = BATCH * SEQ, DFF = 5632, NMODJ = 18432, DEPTH = 4;
constexpr int NH = 16, QLR = 512, KVLR = 512, DN = 128, DR = 64, DV = 128, DQK = 192;
constexpr int NQA = 1280;
constexpr int NQ = NH * DQK;
constexpr float EPS = 1e-6f;
constexpr float QSCALE = 0.07216878364870322f * 1.4426950408889634f;

constexpr size_t MiB = 1u << 20;
constexpr size_t WS_CTL = 0, CTL_ZERO_BYTES = 1 * MiB;
constexpr size_t WS_MOD = 1 * MiB;
constexpr size_t WS_COS = 3 * MiB, WS_SIN = 5 * MiB;
constexpr size_t WS_WGU = 8 * MiB;
constexpr size_t WS_WD = 360 * MiB;
constexpr size_t WS_WPOOL = 536 * MiB;
constexpr size_t WS_WQA = 540 * MiB;
constexpr size_t WS_WUQ = 550 * MiB;
constexpr size_t WS_WUKV = 556 * MiB;
constexpr size_t WS_WO = 564 * MiB;
constexpr size_t WS_H = 580 * MiB;
constexpr size_t WS_HF = 644 * MiB;
constexpr size_t WS_ACT = 772 * MiB;
constexpr size_t WS_F = 948 * MiB;
constexpr size_t WS_POOLED = 1012 * MiB;
constexpr size_t WS_QA = 1076 * MiB;
constexpr size_t WS_CQ = 1156 * MiB;
constexpr size_t WS_CKV = 1172 * MiB;
constexpr size_t WS_Q = 1188 * MiB;
constexpr size_t WS_K = 1284 * MiB;
constexpr size_t WS_VT = 1380 * MiB;
constexpr size_t WS_O = 1444 * MiB;
constexpr size_t WS_END = 1508 * MiB;
constexpr int CW_BAR = 4096;

constexpr int RING_OFF = 0, RING_BYTES = 131072;
constexpr int LDSCTL_OFF = RING_BYTES, MISC_OFF = LDSCTL_OFF + 320;
constexpr int LDS_BYTES = 147456;

#define GAS __attribute__((address_space(1)))
#define LAS __attribute__((address_space(3)))
typedef unsigned short bf16;
typedef unsigned v4u __attribute__((ext_vector_type(4)));
typedef unsigned v2u __attribute__((ext_vector_type(2)));
typedef float f32x4 __attribute__((ext_vector_type(4)));
typedef float f32x16 __attribute__((ext_vector_type(16)));
typedef short bf16x8 __attribute__((ext_vector_type(8)));
typedef short s16x4 __attribute__((ext_vector_type(4)));
typedef GAS unsigned gu32;
#define LDS_WAIT() asm volatile("s_waitcnt lgkmcnt(0)" ::: "memory")
__device__ __forceinline__ unsigned f2bf(float f) { unsigned u = __builtin_bit_cast(unsigned, f); return (u + 0x7fffu + ((u >> 16) & 1u)) >> 16; }
__device__ __forceinline__ unsigned pk2(float lo, float hi) { return f2bf(lo) | (f2bf(hi) << 16); }
__device__ __forceinline__ float bflo(unsigned w) { return __builtin_bit_cast(float, w << 16); }
__device__ __forceinline__ float bfhi(unsigned w) { return __builtin_bit_cast(float, w & 0xffff0000u); }

#define XB_TMO      128
#define XB_XCNT(j)  (256  + 64 * (j))
#define XB_XSUB(j)  (1280 + 64 * (j))
#define XB_XGEN(j)  (2304 + 64 * (j))
#define XB_TOP      3328
#define XB_TOPGEN   3392
#define XCD_BAR_WORDS 3456
#define XB_SPIN_CAP (1u << 18)

__device__ __forceinline__ unsigned xb_ld(unsigned* p)              { return __hip_atomic_load(p, __ATOMIC_RELAXED, __HIP_MEMORY_SCOPE_AGENT); }
__device__ __forceinline__ unsigned xb_add(unsigned* p, unsigned v) { return __hip_atomic_fetch_add(p, v, __ATOMIC_RELAXED, __HIP_MEMORY_SCOPE_AGENT); }
__device__ __forceinline__ unsigned xb_xcc_id() { return (unsigned)__builtin_amdgcn_s_getreg((3 << 11) | 20) & 0xFu; }
#define XB_SPIN(cond, bar) do { unsigned _sp = 0; while (cond) { __builtin_amdgcn_s_sleep(1); \
    if ((++_sp & 255u) == 0u) { if (xb_ld(&(bar)[XB_TMO])) break; if (_sp > XB_SPIN_CAP) { atomicAdd(&(bar)[XB_TMO], 1u); break; } } } } while (0)

struct XcdBarrier { unsigned* bar; unsigned x; volatile LAS unsigned* st; };

__device__ __forceinline__ XcdBarrier xcd_barrier_post(unsigned* bar, volatile LAS unsigned* st) {
    XcdBarrier b; b.bar = bar; b.x = xb_xcc_id(); b.st = st;
    if (threadIdx.x == 0) (void)xb_add(&bar[XB_XCNT(b.x)], 1u);
    return b;
}
__device__ __forceinline__ void xcd_barrier_complete(unsigned* bar, unsigned x, unsigned& nloc, unsigned& nx) {
    const unsigned G = gridDim.x * gridDim.y * gridDim.z;
    unsigned sum, cnt, mine, sp = 0u;
    for (;;) {
        sum = 0u; cnt = 0u; mine = 0u;
#pragma unroll
        for (unsigned j = 0; j < 16; ++j) { const unsigned c = xb_ld(&bar[XB_XCNT(j)]); sum += c; cnt += (c > 0u) ? 1u : 0u; mine = (j == x) ? c : mine; }
        if (sum == G) break;
        __builtin_amdgcn_s_sleep(1);
        if ((++sp & 255u) == 0u) { if (xb_ld(&bar[XB_TMO])) break; if (sp > XB_SPIN_CAP) { atomicAdd(&bar[XB_TMO], 1u); break; } }
    }
    nloc = mine > 0u ? mine : 1u; nx = cnt > 0u ? cnt : 1u;
}
__device__ __forceinline__ void xcd_barrier(const XcdBarrier& b) {
    asm volatile("s_waitcnt vmcnt(0)" ::: "memory");
    __syncthreads();
    if (threadIdx.x == 0) {
        unsigned* bar = b.bar;
        __builtin_amdgcn_s_waitcnt(0);
        unsigned nloc = b.st[0], nx = b.st[1];
        if (nloc == 0u) { xcd_barrier_complete(bar, b.x, nloc, nx); b.st[0] = nloc; b.st[1] = nx; }
        const unsigned old = xb_add(&bar[XB_XSUB(b.x)], 1u);
        const unsigned gen = old / nloc;
        if (old + 1u == (gen + 1u) * nloc) {
            __builtin_amdgcn_fence(__ATOMIC_RELEASE, "agent");
            asm volatile("s_waitcnt vmcnt(0)" ::: "memory");
            const unsigned og = xb_add(&bar[XB_TOP], 1u);
            const unsigned tg = og / nx;
            if (og + 1u == (tg + 1u) * nx) xb_add(&bar[XB_TOPGEN], 1u);
            else XB_SPIN(xb_ld(&bar[XB_TOPGEN]) == tg, bar);
            __builtin_amdgcn_fence(__ATOMIC_ACQUIRE, "agent");
            xb_add(&bar[XB_XGEN(b.x)], 1u);
            asm volatile("s_waitcnt vmcnt(0)" ::: "memory");
        } else {
            XB_SPIN(xb_ld(&bar[XB_XGEN(b.x)]) == gen, bar);
            __builtin_amdgcn_fence(__ATOMIC_ACQUIRE, "agent");
            asm volatile("s_waitcnt vmcnt(0)" ::: "memory");
        }
    }
    __syncthreads();
}

typedef const void* cvp_t;
#define CAS __attribute__((address_space(4)))
struct Frame {
    LAS unsigned char* lds;
    int tid, lane, wave, vcu, G;
    const CAS cvp_t* kin;
    float* out; unsigned char* ws;
};
__device__ __forceinline__ const float* ldarg(const CAS cvp_t* kin, int i) { asm volatile("" : "+s"(kin)); return (const float*)kin[i]; }
#define F_x          ldarg(F.kin, 0)
#define F_c          ldarg(F.kin, 1)
#define F_pos        ((const int*)ldarg(F.kin, 2))
#define F_ada_w      ldarg(F.kin, 3)
#define F_ada_b      ldarg(F.kin, 4)
#define F_norm_pre   ldarg(F.kin, 5)
#define F_norm_post  ldarg(F.kin, 6)
#define F_w_gate     ldarg(F.kin, 7)
#define F_w_up       ldarg(F.kin, 8)
#define F_w_down     ldarg(F.kin, 9)
#define F_pool_w     ldarg(F.kin, 10)
#define F_pool_b     ldarg(F.kin, 11)
#define F_pool_scale ldarg(F.kin, 12)
#define F_w_dq       ldarg(F.kin, 13)
#define F_q_norm     ldarg(F.kin, 14)
#define F_w_uq       ldarg(F.kin, 15)
#define F_w_dkv      ldarg(F.kin, 16)
#define F_kv_norm    ldarg(F.kin, 17)
#define F_w_ukv      ldarg(F.kin, 18)
#define F_w_o        ldarg(F.kin, 19)
__device__ __forceinline__ float wave_sum(float v) {
#pragma unroll
    for (int o = 1; o < 64; o <<= 1) v += __shfl_xor(v, o);
    return v;
}

enum { MAP_ID = 0, MAP_GATE = 1, MAP_UP = 2, MAP_DKV = 3, MAP_UQ = 4, MAP_UKV = 5 };
__device__ __forceinline__ int map_row(int kind, int n, int off) {
    switch (kind) {
        case MAP_GATE: return ((n >> 7) << 8) + (n & 127);
        case MAP_UP:   return ((n >> 7) << 8) + 128 + (n & 127);
        case MAP_DKV:  { if (n < 512) return 512 + n; const int j = n - 512; return 1024 + 2 * (j & 31) + (j >> 5); }
        case MAP_UQ:   { const int h = n / 192, d = n - h * 192; if (d < 128) return n; const int j = d - 128; return h * 192 + 128 + 2 * (j & 31) + (j >> 5); }
        case MAP_UKV:  { const int h = n >> 8, d = n & 255; return d < 128 ? h * 128 + d : 2048 + h * 128 + (d - 128); }
        default:       return off + n;
    }
}
__device__ __forceinline__ void tr_item(const float* W, int K, int N, bf16* WT, int kind, int off, LAS float* scr, int item, int lane) {
    const int nblk = N / 32, kb = item / nblk, nb = item % nblk, k0 = 64 * kb, n0 = 32 * nb;
#pragma unroll 8
    for (int i = 0; i < 32; ++i) { const int kk = 2 * i + (lane >> 5); scr[kk * 33 + (lane & 31)] = W[(size_t)(k0 + kk) * N + n0 + (lane & 31)]; }
    LDS_WAIT(); asm volatile("" ::: "memory");
    const int c = lane & 7;
#pragma unroll
    for (int j = 0; j < 4; ++j) { const int n = (lane >> 3) + 8 * j; const LAS float* s = scr + (8 * c) * 33 + n;
        v4u o; o.x = pk2(s[0 * 33], s[1 * 33]); o.y = pk2(s[2 * 33], s[3 * 33]); o.z = pk2(s[4 * 33], s[5 * 33]); o.w = pk2(s[6 * 33], s[7 * 33]);
        *(GAS v4u*)(WT + (size_t)map_row(kind, n0 + n, off) * K + k0 + 8 * c) = o; }
    LDS_WAIT(); asm volatile("" ::: "memory");
}

constexpr int NIT_FFN = 8 * 3 * 5632, NIT_POOL = 2 * 4 * 128, NIT_MLA1 = 512 + 576 + 768 + 1024 + 2048, NIT_ALL = NIT_FFN + NIT_POOL + 2 * NIT_MLA1;

__device__ __forceinline__ void p0_prologue(Frame& F) {
    {
        LAS float* cact = (LAS float*)(F.lds + RING_OFF);
        LAS float* red = (LAS float*)(F.lds + RING_OFF + 32768);
        for (int i = F.tid; i < 4 * D; i += NWAVES * 64) { const int b = i / D, k = i % D; const float v = F_c[i]; cact[k * 4 + b] = v / (1.0f + __expf(-v)); }
        __syncthreads();
        float* mod = (float*)(F.ws + WS_MOD);
        for (int it = blockIdx.x; it < 4 * (NMODJ / 64); it += F.G) {
            const int l = it / (NMODJ / 64), j0 = (it % (NMODJ / 64)) * 64;
            const float* wp = F_ada_w + ((size_t)l * D + F.wave * 256) * NMODJ + j0 + F.lane;
            float a0 = 0.f, a1 = 0.f, a2 = 0.f, a3 = 0.f;
#pragma unroll 16
            for (int kk = 0; kk < 256; ++kk) { const float w = wp[(size_t)kk * NMODJ]; const f32x4 ca = *(const LAS f32x4*)(cact + (F.wave * 256 + kk) * 4);
                a0 += ca[0] * w; a1 += ca[1] * w; a2 += ca[2] * w; a3 += ca[3] * w; }
            red[(F.wave * 4 + 0) * 64 + F.lane] = a0; red[(F.wave * 4 + 1) * 64 + F.lane] = a1; red[(F.wave * 4 + 2) * 64 + F.lane] = a2; red[(F.wave * 4 + 3) * 64 + F.lane] = a3;
            __syncthreads();
            if (F.tid < 256) { const int b = F.tid >> 6, ln = F.tid & 63; float s = 0.f;
#pragma unroll
                for (int w = 0; w < 8; ++w) s += red[(w * 4 + b) * 64 + ln];
                mod[((size_t)l * 4 + b) * NMODJ + j0 + ln] = s + F_ada_b[(size_t)l * NMODJ + j0 + ln]; }
            __syncthreads();
        }
    }
    {
        float* cosT = (float*)(F.ws + WS_COS); float* sinT = (float*)(F.ws + WS_SIN);
        for (int i = blockIdx.x * (NWAVES * 64) + F.tid; i < M * 32; i += F.G * NWAVES * 64) {
            const int row = i >> 5, fi = i & 31;
            const float inv_freq = exp2f(-(float)(2 * fi) * (1.0f / 64.0f) * 13.287712379549449f);
            const float ang = (float)F_pos[row] * inv_freq;
            double t = (double)ang * 0.15915494309189535; t -= floor(t);
            const float tf = (float)t;
            cosT[i] = __builtin_amdgcn_cosf(tf); sinT[i] = __builtin_amdgcn_sinf(tf);
        }
    }
    {
        for (int ml = 0; ml < 2; ++ml) { v4u* p = (v4u*)(F.ws + WS_WQA + (size_t)ml * NQA * D * 2 + (size_t)1088 * D * 2); const int n16 = (NQA - 1088) * D * 2 / 16;
            for (int i = blockIdx.x * (NWAVES * 64) + F.tid; i < n16; i += F.G * NWAVES * 64) p[i] = (v4u){0u, 0u, 0u, 0u}; }
    }
    {
        LAS float* scr = (LAS float*)(F.lds + RING_OFF + F.wave * 16384);
        const int gw = blockIdx.x * NWAVES + F.wave, NGW = F.G * NWAVES;
        for (int it = gw; it < NIT_ALL; it += NGW) {
            if (it < NIT_FFN) { const int lf = it / 16896, r = it % 16896, kind = r / 5632, sub = r % 5632;
                if (kind == 0) tr_item(F_w_gate + (size_t)lf * D * DFF, D, DFF, (bf16*)(F.ws + WS_WGU) + (size_t)lf * 2 * DFF * D, MAP_GATE, 0, scr, sub, F.lane);
                else if (kind == 1) tr_item(F_w_up + (size_t)lf * D * DFF, D, DFF, (bf16*)(F.ws + WS_WGU) + (size_t)lf * 2 * DFF * D, MAP_UP, 0, scr, sub, F.lane);
                else tr_item(F_w_down + (size_t)lf * DFF * D, DFF, D, (bf16*)(F.ws + WS_WD) + (size_t)lf * D * DFF, MAP_ID, 0, scr, sub, F.lane);
            } else if (it < NIT_FFN + NIT_POOL) { const int r = it - NIT_FFN, pl = r / 512, g = (r % 512) / 128, sub = r % 128;
                tr_item(F_pool_w + (size_t)(pl * 4 + g) * 512 * 512, 512, 512, (bf16*)(F.ws + WS_WPOOL) + (size_t)pl * D * 512, MAP_ID, g * 512, scr, sub, F.lane);
            } else { int r = it - NIT_FFN - NIT_POOL; const int ml = r / NIT_MLA1; r %= NIT_MLA1;
                if (r < 512) tr_item(F_w_dq + (size_t)ml * D * QLR, D, QLR, (bf16*)(F.ws + WS_WQA) + (size_t)ml * NQA * D, MAP_ID, 0, scr, r, F.lane);
                else if (r < 1088) tr_item(F_w_dkv + (size_t)ml * D * 576, D, 576, (bf16*)(F.ws + WS_WQA) + (size_t)ml * NQA * D, MAP_DKV, 0, scr, r - 512, F.lane);
                else if (r < 1856) tr_item(F_w_uq + (size_t)ml * QLR * NQ, QLR, NQ, (bf16*)(F.ws + WS_WUQ) + (size_t)ml * NQ * QLR, MAP_UQ, 0, scr, r - 1088, F.lane);
                else if (r < 2880) tr_item(F_w_ukv + (size_t)ml * KVLR * 4096, KVLR, 4096, (bf16*)(F.ws + WS_WUKV) + (size_t)ml * 4096 * KVLR, MAP_UKV, 0, scr, r - 1856, F.lane);
                else tr_item(F_w_o + (size_t)ml * D * D, D, D, (bf16*)(F.ws + WS_WO) + (size_t)ml * D * D, MAP_ID, 0, scr, r - 2880, F.lane);
            }
        }
    }
}

__device__ __forceinline__ void norm_phase(Frame& F, const float* xsrc, float* xdst, const bf16* fin, const float* gpost, const float* modpost  , float wgt,
                                           const float* gpre, const float* modpre, bf16* hb, float* hf) {
    LAS float* V1 = (LAS float*)(F.lds + RING_OFF); LAS float* V2 = V1 + D; LAS float* V3 = V2 + D;
    const bool has_post = fin != nullptr, has_pre = gpre != nullptr;
    for (int chunk = blockIdx.x; chunk < M / 64; chunk += F.G) {
        const int r0 = chunk * 64, b = r0 / SEQ, c4 = F.tid * 4;
        {
            f32x4 a1 = {0.f, 0.f, 0.f, 0.f}, a2 = a1, a3 = a1;
            if (has_post) { const f32x4 gp = *(const f32x4*)(gpost + c4), gt = *(const f32x4*)(modpost + (size_t)b * NMODJ + 2 * D + c4); a1 = wgt * gp * (1.0f + gt); }
            if (has_pre) { const f32x4 gp = *(const f32x4*)(gpre + c4), sc = *(const f32x4*)(modpre + (size_t)b * NMODJ + D + c4); a2 = gp * (1.0f + sc); a3 = *(const f32x4*)(modpre + (size_t)b * NMODJ + c4); }
            *(LAS f32x4*)(V1 + c4) = a1; *(LAS f32x4*)(V2 + c4) = a2; *(LAS f32x4*)(V3 + c4) = a3;
        }
        __syncthreads();
#pragma unroll 1
        for (int i = 0; i < 8; ++i) {
            const int row = r0 + F.wave * 8 + i; const size_t ro = (size_t)row * D + 4 * F.lane;
            f32x4 xv[8];
#pragma unroll
            for (int j = 0; j < 8; ++j) xv[j] = *(const f32x4*)(xsrc + ro + 256 * j);
            if (has_post) {
                v2u fv[8]; float ss = 0.f;
#pragma unroll
                for (int j = 0; j < 8; ++j) { fv[j] = *(const v2u*)(fin + ro + 256 * j); const float f0 = bflo(fv[j].x), f1 = bfhi(fv[j].x), f2 = bflo(fv[j].y), f3 = bfhi(fv[j].y); ss += (f0 * f0 + f1 * f1) + (f2 * f2 + f3 * f3); }
                const float rstd = 1.0f / sqrtf(wave_sum(ss) * (1.0f / D) + EPS);
#pragma unroll
                for (int j = 0; j < 8; ++j) { const f32x4 a1 = *(const LAS f32x4*)(V1 + 4 * F.lane + 256 * j); const f32x4 fvv = {bflo(fv[j].x), bfhi(fv[j].x), bflo(fv[j].y), bfhi(fv[j].y)};
                    xv[j] = xv[j] + a1 * (fvv * rstd); *(f32x4*)(xdst + ro + 256 * j) = xv[j]; }
            }
            if (has_pre) {
                float ss = 0.f;
#pragma unroll
                for (int j = 0; j < 8; ++j) ss += (xv[j].x * xv[j].x + xv[j].y * xv[j].y) + (xv[j].z * xv[j].z + xv[j].w * xv[j].w);
                const float rstd = 1.0f / sqrtf(wave_sum(ss) * (1.0f / D) + EPS);
#pragma unroll
                for (int j = 0; j < 8; ++j) { const f32x4 a2 = *(const LAS f32x4*)(V2 + 4 * F.lane + 256 * j), a3 = *(const LAS f32x4*)(V3 + 4 * F.lane + 256 * j);
                    const f32x4 hv = xv[j] * rstd * a2 + a3;
                    if (hf) *(f32x4*)(hf + ro + 256 * j) = hv;
                    else { v2u o; o.x = pk2(hv.x, hv.y); o.y = pk2(hv.z, hv.w); *(v2u*)(hb + ro + 256 * j) = o; } }
            }
        }
        __syncthreads();
    }
}

__device__ __forceinline__ void pool_window_phase(Frame& F, const float* hf, bf16* pooled) {
    const int gw = blockIdx.x * NWAVES + F.wave, NGW = F.G * NWAVES;
    for (int blk = gw; blk < M / 8; blk += NGW) {
        const int t0 = blk * 8, ts0 = t0 % SEQ;
#pragma unroll 1
        for (int j = 0; j < 8; ++j) {
            const int w = 2 << (j >> 1); const size_t co = 4 * F.lane + 256 * j;
            f32x4 S = {0.f, 0.f, 0.f, 0.f};
            const int lo = ts0 - w > 0 ? ts0 - w : 0;
            for (int ti = lo; ti < ts0; ++ti) S = S + *(const f32x4*)(hf + (size_t)(t0 - ts0 + ti) * D + co);
#pragma unroll 1
            for (int r = 0; r < 8; ++r) {
                const int t = ts0 + r; const f32x4 hv = *(const f32x4*)(hf + (size_t)(t0 + r) * D + co);
                S = S + hv;
                if (t - w >= 0) S = S - *(const f32x4*)(hf + (size_t)(t0 + r - w) * D + co);
                const float inv = 1.0f / (float)(t + 1 < w ? t + 1 : w);
                const f32x4 pv = S * inv - hv;
                v2u o; o.x = pk2(pv.x, pv.y); o.y = pk2(pv.z, pv.w); *(v2u*)(pooled + (size_t)(t0 + r) * D + co) = o;
            }
        }
    }
}

__device__ __forceinline__ void mla_mid_phase(Frame& F, const float* QA, const float* qn, const float* kvn, bf16* cq, bf16* ckv, bf16* Kb) {
    const int gw = blockIdx.x * NWAVES + F.wave, NGW = F.G * NWAVES;
    const float* cosT = (const float*)(F.ws + WS_COS); const float* sinT = (const float*)(F.ws + WS_SIN);
    const f32x4 qn0 = *(const f32x4*)(qn + 8 * F.lane), qn1 = *(const f32x4*)(qn + 8 * F.lane + 4), kn0 = *(const f32x4*)(kvn + 8 * F.lane), kn1 = *(const f32x4*)(kvn + 8 * F.lane + 4);
    for (int row = gw; row < M; row += NGW) {
        const float* qa = QA + (size_t)row * NQA;
        { f32x4 v0 = *(const f32x4*)(qa + 8 * F.lane), v1 = *(const f32x4*)(qa + 8 * F.lane + 4);
          const float ss = (v0.x * v0.x + v0.y * v0.y) + (v0.z * v0.z + v0.w * v0.w) + (v1.x * v1.x + v1.y * v1.y) + (v1.z * v1.z + v1.w * v1.w);
          const float rstd = 1.0f / sqrtf(wave_sum(ss) * (1.0f / 512.0f) + EPS); v0 = v0 * rstd * qn0; v1 = v1 * rstd * qn1;
          v4u o; o.x = pk2(v0.x, v0.y); o.y = pk2(v0.z, v0.w); o.z = pk2(v1.x, v1.y); o.w = pk2(v1.z, v1.w); *(v4u*)(cq + (size_t)row * 512 + 8 * F.lane) = o; }
        { f32x4 v0 = *(const f32x4*)(qa + 512 + 8 * F.lane), v1 = *(const f32x4*)(qa + 512 + 8 * F.lane + 4);
          const float ss = (v0.x * v0.x + v0.y * v0.y) + (v0.z * v0.z + v0.w * v0.w) + (v1.x * v1.x + v1.y * v1.y) + (v1.z * v1.z + v1.w * v1.w);
          const float rstd = 1.0f / sqrtf(wave_sum(ss) * (1.0f / 512.0f) + EPS); v0 = v0 * rstd * kn0; v1 = v1 * rstd * kn1;
          v4u o; o.x = pk2(v0.x, v0.y); o.y = pk2(v0.z, v0.w); o.z = pk2(v1.x, v1.y); o.w = pk2(v1.z, v1.w); *(v4u*)(ckv + (size_t)row * 512 + 8 * F.lane) = o; }
        if (F.lane < 32) { const float x1 = qa[1024 + 2 * F.lane], x2 = qa[1024 + 2 * F.lane + 1], cs = cosT[(size_t)row * 32 + F.lane], sn = sinT[(size_t)row * 32 + F.lane];
            const unsigned o = pk2(x1 * cs - x2 * sn, x2 * cs + x1 * sn); unsigned* kp = (unsigned*)(Kb + (size_t)row * NQ + 128 + 2 * F.lane);
#pragma unroll
            for (int h = 0; h < NH; ++h) kp[h * (DQK / 2)] = o; }
    }
}

namespace att {
constexpr int KSTR = 400, VSTR = 136, KBUF = 64 * KSTR, VBUF = 128 * VSTR, BUF = KBUF + VBUF;
static_assert(2 * BUF <= RING_BYTES, "attention LDS");
__device__ __forceinline__ int crow(int r, int hi) { return (r & 3) + 8 * (r >> 2) + 4 * hi; }
__device__ __forceinline__ void unit(LAS unsigned char* lds, const bf16* Q, const bf16* Kg, const bf16* VT, bf16* O, int b, int h, int qb, int tid, int wave, int lane) {
    const int q0 = b * SEQ + qb * 256, ntiles = 4 * (qb + 1), l31 = lane & 31, hi = lane >> 5;
    bf16x8 qf[12];
    { const bf16* qp = Q + (size_t)(q0 + 32 * wave + l31) * NQ + h * DQK + 8 * hi;
#pragma unroll
      for (int ks = 0; ks < 12; ++ks) qf[ks] = *(const bf16x8*)(qp + 16 * ks); }
    f32x16 o[4];
#pragma unroll
    for (int db = 0; db < 4; ++db)
#pragma unroll
        for (int r = 0; r < 16; ++r) o[db][r] = 0.f;
    float mrun = -1e30f, lrun = 0.f;
    const bf16* kbase = Kg + (size_t)(b * SEQ) * NQ + h * DQK;
    const bf16* vbase = VT + (size_t)(h * DV) * M + b * SEQ;
    const int kgo = (tid >> 3) * NQ + (tid & 7) * 8, klo = (tid >> 3) * KSTR + (tid & 7) * 16;
    const int vgo = (tid >> 2) * M + (tid & 3) * 8, vlo = KBUF + (tid >> 2) * VSTR + (tid & 3) * 16;
    v4u kr[3], vr[2];
#define ATT_LOAD(jt) do { const bf16* kp_ = kbase + (size_t)(jt) * 64 * NQ + kgo; const bf16* vp_ = vbase + (jt) * 64 + vgo; \
                          _Pragma("unroll") for (int i = 0; i < 3; ++i) kr[i] = *(const v4u*)(kp_ + 64 * i); \
                          _Pragma("unroll") for (int i = 0; i < 2; ++i) vr[i] = *(const v4u*)(vp_ + 32 * i); } while (0)
#define ATT_WRITE(bufo) do { _Pragma("unroll") for (int i = 0; i < 3; ++i) *(LAS v4u*)(lds + (bufo) + klo + 128 * i) = kr[i]; \
                             _Pragma("unroll") for (int i = 0; i < 2; ++i) { *(LAS v2u*)(lds + (bufo) + vlo + 64 * i) = (v2u){vr[i].x, vr[i].y}; *(LAS v2u*)(lds + (bufo) + vlo + 64 * i + 8) = (v2u){vr[i].z, vr[i].w}; } } while (0)
    ATT_LOAD(0); ATT_WRITE(0);
    __syncthreads();
    const int qrel = 32 * wave + l31;
#pragma unroll 1
    for (int jt = 0; jt < ntiles; ++jt) {
        const bool more = jt + 1 < ntiles;
        if (more) ATT_LOAD(jt + 1);
        const int cur = (jt & 1) * BUF;
        const int krel0 = 64 * (jt - 4 * qb);
        if (krel0 <= 32 * wave + 31) {
            f32x16 p0, p1;
#pragma unroll
            for (int r = 0; r < 16; ++r) { p0[r] = 0.f; p1[r] = 0.f; }
            const LAS unsigned char* kb = lds + cur + l31 * KSTR + hi * 16;
#pragma unroll
            for (int ks = 0; ks < 12; ++ks) { const bf16x8 a0 = *(const LAS bf16x8*)(kb + ks * 32), a1 = *(const LAS bf16x8*)(kb + 32 * KSTR + ks * 32);
                p0 = __builtin_amdgcn_mfma_f32_32x32x16_bf16(a0, qf[ks], p0, 0, 0, 0); p1 = __builtin_amdgcn_mfma_f32_32x32x16_bf16(a1, qf[ks], p1, 0, 0, 0); }
            if (krel0 + 63 > 32 * wave) {
                const float NEG = -__builtin_inff();
#pragma unroll
                for (int r = 0; r < 16; ++r) { const int kk = krel0 + crow(r, hi); if (kk > qrel) p0[r] = NEG; if (kk + 32 > qrel) p1[r] = NEG; }
            }
            float mx = p0[0];
#pragma unroll
            for (int r = 1; r < 16; ++r) mx = fmaxf(mx, p0[r]);
#pragma unroll
            for (int r = 0; r < 16; ++r) mx = fmaxf(mx, p1[r]);
            mx = fmaxf(mx, __shfl_xor(mx, 32));
            const float mn = fmaxf(mrun, mx), alpha = __builtin_amdgcn_exp2f(mrun - mn); mrun = mn;
            float ps = 0.f;
#pragma unroll
            for (int r = 0; r < 16; ++r) { p0[r] = __builtin_amdgcn_exp2f(p0[r] - mn); p1[r] = __builtin_amdgcn_exp2f(p1[r] - mn); ps += p0[r] + p1[r]; }
            ps += __shfl_xor(ps, 32);
            lrun = lrun * alpha + ps;
#pragma unroll
            for (int db = 0; db < 4; ++db)
#pragma unroll
                for (int r = 0; r < 16; ++r) o[db][r] *= alpha;
            bf16x8 pf[2][2];
#pragma unroll
            for (int s = 0; s < 2; ++s) {
                v4u w0, w1;
                w0.x = pg8::cvt_pk_bf16(p0[8 * s + 0], p0[8 * s + 1]); w0.y = pg8::cvt_pk_bf16(p0[8 * s + 2], p0[8 * s + 3]); w0.z = pg8::cvt_pk_bf16(p0[8 * s + 4], p0[8 * s + 5]); w0.w = pg8::cvt_pk_bf16(p0[8 * s + 6], p0[8 * s + 7]);
                w1.x = pg8::cvt_pk_bf16(p1[8 * s + 0], p1[8 * s + 1]); w1.y = pg8::cvt_pk_bf16(p1[8 * s + 2], p1[8 * s + 3]); w1.z = pg8::cvt_pk_bf16(p1[8 * s + 4], p1[8 * s + 5]); w1.w = pg8::cvt_pk_bf16(p1[8 * s + 6], p1[8 * s + 7]);
                pf[0][s] = __builtin_bit_cast(bf16x8, w0); pf[1][s] = __builtin_bit_cast(bf16x8, w1);
            }
            const LAS unsigned char* vb = lds + cur + KBUF + l31 * VSTR + hi * 8;
#pragma unroll
            for (int db = 0; db < 4; ++db)
#pragma unroll
                for (int kb2 = 0; kb2 < 2; ++kb2)
#pragma unroll
                    for (int s = 0; s < 2; ++s) { const LAS unsigned char* ap = vb + db * 32 * VSTR + (32 * kb2 + 16 * s) * 2;
                        const v2u lo = *(const LAS v2u*)ap, hi4 = *(const LAS v2u*)(ap + 16);
                        const v4u av = {lo.x, lo.y, hi4.x, hi4.y};
                        o[db] = __builtin_amdgcn_mfma_f32_32x32x16_bf16(__builtin_bit_cast(bf16x8, av), pf[kb2][s], o[db], 0, 0, 0); }
        }
        if (more) ATT_WRITE(((jt + 1) & 1) * BUF);
        __syncthreads();
    }
#undef ATT_LOAD
#undef ATT_WRITE
    const float inv = 1.0f / lrun;
    bf16* op = O + (size_t)(q0 + qrel) * D + h * DV + 4 * hi;
#pragma unroll
    for (int db = 0; db < 4; ++db)
#pragma unroll
        for (int g = 0; g < 4; ++g) { v2u w; w.x = pg8::cvt_pk_bf16(o[db][4 * g] * inv, o[db][4 * g + 1] * inv); w.y = pg8::cvt_pk_bf16(o[db][4 * g + 2] * inv, o[db][4 * g + 3] * inv);
            *(v2u*)(op + 32 * db + 8 * g) = w; }
}
__device__ __forceinline__ void phase(Frame& F, const bf16* Q, const bf16* Kg, const bf16* VT, bf16* O) {
    for (int it = F.vcu; it < BATCH * NH * 8; it += F.G) {
        const int bh = it >> 3, s = it & 7, b = bh / NH, h = bh % NH;
        unit(F.lds + RING_OFF, Q, Kg, VT, O, b, h, 15 - s, F.tid, F.wave, F.lane);
        unit(F.lds + RING_OFF, Q, Kg, VT, O, b, h, s, F.tid, F.wave, F.lane);
    }
}
}

struct Args { const void* in[20]; float* out; unsigned char* ws; int ph_lo, ph_hi; };
constexpr int N_PHASES = 2 + DEPTH * 6 + 2 * 3 + 2 * 6;

__device__ __forceinline__ const float* modp(const Frame& F, int layer, int sub) { return (const float*)(F.ws + WS_MOD) + (size_t)layer * 4 * NMODJ + (size_t)sub * 3 * D; }

#define GRID_BAR() xcd_barrier(bar)
#define PH_BEGIN if (ph >= lo && ph < hi) { { int t_ = threadIdx.x; asm volatile("" : "+v"(t_)); F.tid = t_; F.lane = t_ & 63; F.wave = __builtin_amdgcn_readfirstlane(t_ >> 6); }
#define PH_END   if (ph + 1 < hi) GRID_BAR(); } ++ph;

#define FFN_SUBLAYER(layer, fidx, sub, xsrc_, nl, ns, hf_) do { \
    const int lf_ = (layer) * 2 + (fidx); \
    PH_BEGIN { pg8::Gemm g{(const bf16*)(F.ws + WS_H), (const bf16*)(F.ws + WS_WGU) + (size_t)lf_ * 2 * DFF * D, M, 2 * DFF, D, D, D, 0, 0}; pg8::StaticOrder S; S.init(M, 2 * DFF, F.G, (int)blockIdx.x); \
        pg8::EpiSwiGLU E{(bf16*)(F.ws + WS_ACT), DFF}; pg8::gemm_phase<pg8::EpiSwiGLU, pg8::StaticOrder, true, true>(F.lds + RING_OFF, g, S, E, F.tid); } PH_END \
    PH_BEGIN { pg8::Gemm g{(const bf16*)(F.ws + WS_ACT), (const bf16*)(F.ws + WS_WD) + (size_t)lf_ * D * DFF, M, D, DFF, DFF, DFF, 0, 0}; pg8::StaticOrder S; S.init(M, D, F.G, (int)blockIdx.x); \
        pg8::EpiBf16G E{(bf16*)(F.ws + WS_F), D, 128, nullptr, nullptr}; pg8::gemm_phase<pg8::EpiBf16G, pg8::StaticOrder, true, true>(F.lds + RING_OFF, g, S, E, F.tid); } PH_END \
    PH_BEGIN { const bool hn_ = (nl) < DEPTH; \
        norm_phase(F, (xsrc_), F.out, (const bf16*)(F.ws + WS_F), F_norm_post + ((size_t)(layer) * 3 + (sub)) * D, modp(F, (layer), (sub)), 0.5f, \
                   hn_ ? F_norm_pre + ((size_t)(nl) * 3 + (ns)) * D : nullptr, hn_ ? modp(F, (nl), (ns)) : nullptr, (bf16*)(F.ws + WS_H), (hf_) ? (float*)(F.ws + WS_HF) : nullptr); } PH_END \
} while (0)

__global__ void __launch_bounds__(NWAVES * 64, 2) mk_fwd(Args args) {
    extern __shared__ __attribute__((aligned(16))) unsigned char lds[];
    Frame F;
    F.lds = (LAS unsigned char*)lds;
    F.tid = threadIdx.x; F.lane = F.tid & 63; F.wave = __builtin_amdgcn_readfirstlane(F.tid >> 6);
    F.G = gridDim.x; { const int bx = blockIdx.x; F.vcu = (F.G % 8 == 0) ? (bx % 8) * (F.G / 8) + bx / 8 : bx; }
    F.kin = (const CAS cvp_t*)__builtin_amdgcn_kernarg_segment_ptr();
    F.out = args.out; F.ws = args.ws;
    for (int u = F.tid; u < (LDS_BYTES - LDSCTL_OFF) / 4; u += NWAVES * 64) ((LAS unsigned*)(F.lds + LDSCTL_OFF))[u] = 0u;
    __syncthreads();
    XcdBarrier bar = xcd_barrier_post((unsigned*)(F.ws + WS_CTL) + CW_BAR, (volatile LAS unsigned*)(F.lds + MISC_OFF) + 8);
    const int lo = args.ph_lo, hi = args.ph_hi;
    int ph = 0;

    PH_BEGIN {
#ifndef NO_P0
 p0_prologue(F);
#endif
 } PH_END
    PH_BEGIN { norm_phase(F, F_x, F.out, nullptr, nullptr, nullptr, 0.f, F_norm_pre, modp(F, 0, 0), (bf16*)(F.ws + WS_H), nullptr); } PH_END

#pragma unroll 1
    for (int lp = 0; lp < NLP; ++lp) {
        const int l0 = 2 * lp, l1 = 2 * lp + 1;
        FFN_SUBLAYER(l0, 0, 0, (lp == 0 ? F_x : (const float*)F.out), l0, 1, true);
        PH_BEGIN { pool_window_phase(F, (const float*)(F.ws + WS_HF), (bf16*)(F.ws + WS_POOLED)); } PH_END
        PH_BEGIN { pg8::Gemm g{(const bf16*)(F.ws + WS_POOLED), (const bf16*)(F.ws + WS_WPOOL) + (size_t)lp * D * 512, M, D, 512, D, 512, 1, 512}; pg8::StaticOrder S; S.init(M, D, F.G, (int)blockIdx.x);
            pg8::EpiBf16G E{(bf16*)(F.ws + WS_F), D, 128, F_pool_b + (size_t)lp * D, F_pool_scale + (size_t)lp * D}; pg8::gemm_phase<pg8::EpiBf16G, pg8::StaticOrder, true, true>(F.lds + RING_OFF, g, S, E, F.tid); } PH_END
        PH_BEGIN { norm_phase(F, F.out, F.out, (const bf16*)(F.ws + WS_F), F_norm_post + ((size_t)l0 * 3 + 1) * D, modp(F, l0, 1), 1.0f, F_norm_pre + ((size_t)l0 * 3 + 2) * D, modp(F, l0, 2), (bf16*)(F.ws + WS_H), nullptr); } PH_END
        FFN_SUBLAYER(l0, 1, 2, (const float*)F.out, l1, 0, false);
        FFN_SUBLAYER(l1, 0, 0, (const float*)F.out, l1, 1, false);
        PH_BEGIN { pg8::Gemm g{(const bf16*)(F.ws + WS_H), (const bf16*)(F.ws + WS_WQA) + (size_t)lp * NQA * D, M, NQA, D, D, D, 0, 0}; pg8::StaticOrder S; S.init(M, NQA, F.G, (int)blockIdx.x);
            pg8::EpiF32 E{(float*)(F.ws + WS_QA), NQA}; pg8::gemm_phase<pg8::EpiF32, pg8::StaticOrder, true, true>(F.lds + RING_OFF, g, S, E, F.tid); } PH_END
        PH_BEGIN { mla_mid_phase(F, (const float*)(F.ws + WS_QA), F_q_norm + (size_t)lp * QLR, F_kv_norm + (size_t)lp * KVLR, (bf16*)(F.ws + WS_CQ), (bf16*)(F.ws + WS_CKV), (bf16*)(F.ws + WS_K)); } PH_END
        PH_BEGIN {
            { pg8::Gemm g{(const bf16*)(F.ws + WS_CQ), (const bf16*)(F.ws + WS_WUQ) + (size_t)lp * NQ * QLR, M, NQ, QLR, QLR, QLR, 0, 0}; pg8::StaticOrder S; S.init(M, NQ, F.G, (int)blockIdx.x);
              pg8::EpiQ E{(bf16*)(F.ws + WS_Q), (const float*)(F.ws + WS_COS), (const float*)(F.ws + WS_SIN), QSCALE}; pg8::gemm_phase<pg8::EpiQ, pg8::StaticOrder, true, true>(F.lds + RING_OFF, g, S, E, F.tid); }
            { pg8::Gemm g{(const bf16*)(F.ws + WS_CKV), (const bf16*)(F.ws + WS_WUKV) + (size_t)lp * 4096 * KVLR, M, D, KVLR, KVLR, KVLR, 0, 0}; pg8::StaticOrder S; S.init(M, D, F.G, (int)blockIdx.x);
              pg8::EpiBf16G E{(bf16*)(F.ws + WS_K), NQ, DQK, nullptr, nullptr}; pg8::gemm_phase<pg8::EpiBf16G, pg8::StaticOrder, true, true>(F.lds + RING_OFF, g, S, E, F.tid); }
            { pg8::Gemm g{(const bf16*)(F.ws + WS_WUKV) + (size_t)lp * 4096 * KVLR + (size_t)2048 * KVLR, (const bf16*)(F.ws + WS_CKV), D, M, KVLR, KVLR, KVLR, 0, 0}; pg8::StaticOrder S; S.init(D, M, F.G, (int)blockIdx.x);
              pg8::EpiBf16G E{(bf16*)(F.ws + WS_VT), M, 128, nullptr, nullptr}; pg8::gemm_phase<pg8::EpiBf16G, pg8::StaticOrder, true, true>(F.lds + RING_OFF, g, S, E, F.tid); }
        } PH_END
        PH_BEGIN {
#ifndef NO_ATT
 att::phase(F, (const bf16*)(F.ws + WS_Q), (const bf16*)(F.ws + WS_K), (const bf16*)(F.ws + WS_VT), (bf16*)(F.ws + WS_O));
#endif
 } PH_END
        PH_BEGIN { pg8::Gemm g{(const bf16*)(F.ws + WS_O), (const bf16*)(F.ws + WS_WO) + (size_t)lp * D * D, M, D, D, D, D, 0, 0}; pg8::StaticOrder S; S.init(M, D, F.G, (int)blockIdx.x);
            pg8::EpiBf16G E{(bf16*)(F.ws + WS_F), D, 128, nullptr, nullptr}; pg8::gemm_phase<pg8::EpiBf16G, pg8::StaticOrder, true, true>(F.lds + RING_OFF, g, S, E, F.tid); } PH_END
        PH_BEGIN { norm_phase(F, F.out, F.out, (const bf16*)(F.ws + WS_F), F_norm_post + ((size_t)l1 * 3 + 1) * D, modp(F, l1, 1), 1.0f, F_norm_pre + ((size_t)l1 * 3 + 2) * D, modp(F, l1, 2), (bf16*)(F.ws + WS_H), nullptr); } PH_END
        FFN_SUBLAYER(l1, 1, 2, (const float*)F.out, l1 + 1, 0, false);
    }
}

extern "C" void kernel_launch(void* const* d_in, const int* in_sizes, int n_in, void* d_out, int out_size, void* d_ws, size_t ws_size, hipStream_t stream) {
    static int grid = 0;
    if (grid == 0) {
        if (n_in != 20 || in_sizes[0] != M * D || out_size != M * D || ws_size < WS_END) { fprintf(stderr, "kernel_launch: unexpected shapes (n_in %d, in0 %d, out %d, ws %zu); nothing launched\n", n_in, n_in > 0 ? in_sizes[0] : -1, out_size, ws_size); grid = -1; return; }
        int dev = 0, cus = 0, per_cu = 0;
        if (hipGetDevice(&dev) != hipSuccess || hipDeviceGetAttribute(&cus, hipDeviceAttributeMultiprocessorCount, dev) != hipSuccess) { fprintf(stderr, "kernel_launch: device query failed\n"); grid = -1; return; }
        if (hipFuncSetAttribute((const void*)mk_fwd, hipFuncAttributeMaxDynamicSharedMemorySize, LDS_BYTES) != hipSuccess) { fprintf(stderr, "kernel_launch: hipFuncSetAttribute failed\n"); grid = -1; return; }
        if (hipOccupancyMaxActiveBlocksPerMultiprocessor(&per_cu, (const void*)mk_fwd, NWAVES * 64, LDS_BYTES) != hipSuccess || per_cu < 1)
            fprintf(stderr, "kernel_launch: note: occupancy query reports %d workgroups per CU\n", per_cu);
        (void)hipGetLastError();
        grid = cus;
    }
    if (grid < 0) return;
    if (hipMemsetAsync((char*)d_ws + WS_CTL, 0, CTL_ZERO_BYTES, stream) != hipSuccess) { fprintf(stderr, "kernel_launch: memset failed\n"); return; }
    Args a{};
    for (int i = 0; i < 20; ++i) a.in[i] = d_in[i];
    a.out = (float*)d_out; a.ws = (unsigned char*)d_ws;
#if MK_ONE_LAUNCH
    a.ph_lo = 0; a.ph_hi = N_PHASES;
    hipLaunchKernelGGL(mk_fwd, dim3(grid), dim3(NWAVES * 64), LDS_BYTES, stream, a);
#else
    for (int p = 0; p < N_PHASES; ++p) { a.ph_lo = p; a.ph_hi = p + 1; hipLaunchKernelGGL(mk_fwd, dim3(grid), dim3(NWAVES * 64), LDS_BYTES, stream, a); }
#endif
    const hipError_t le = hipPeekAtLastError();
    if (le != hipSuccess) fprintf(stderr, "kernel_launch: launch failed: %s\n", hipGetErrorName(le));
}
```

```cpp
#include <hip/hip_runtime.h>
#include <cstdio>
#include <cstdint>

#ifndef NLP
#define NLP (DEPTH / 2)
#endif
#ifndef MK_ONE_LAUNCH
#define MK_ONE_LAUNCH 1
#endif

namespace pg8 {
#define PG8_LAS __attribute__((address_space(3)))
typedef unsigned short bf16_t;
typedef short bf16x8 __attribute__((ext_vector_type(8)));
typedef float f32x4 __attribute__((ext_vector_type(4)));
typedef unsigned u32x4 __attribute__((ext_vector_type(4)));
constexpr int BM = 256, BK = 64, HALF = 128, HTB = HALF * BK * 2, STAGE_BYTES = 8 * HTB, NXCD = 8, WGM = 8;

__host__ __device__ __forceinline__ int lds_byte(int r, int c) { const int st = (r >> 4) * 2 + (c >> 5), rr = r & 15, cc = c & 31, ob = rr * 64 + cc * 2; return st * 1024 + (ob ^ (((ob >> 9) & 1) << 5)); }
__host__ __device__ __forceinline__ void stage_rc(int b, int& R, int& C) { const int st = b / 1024, sb = b % 1024, swz = sb ^ (((sb >> 9) & 1) << 5); R = (st >> 1) * 16 + swz / 64; C = (st & 1) * 32 + (swz % 64) / 2; }
__host__ __device__ __forceinline__ int perm32(int rho) { const int n = rho >> 4, i = rho & 15; return 8 * (i >> 2) + 4 * n + (i & 3); }

struct Unit { int pm, pn; };
struct Gemm { const bf16_t* A; const bf16_t* Bt; int M, N, K, lda, ldb, ashift, astep; };

struct StaticOrder {
    int nM, nN, nwg, G, c;
    __host__ __device__ void init(int M, int N, int G_, int c_) { nM = M / BM; nN = N / BM; nwg = nM * nN; G = G_; c = c_; }
    __host__ __device__ bool next(int i, Unit& u) const {
        const long L = (long)i * G + c; if (L >= nwg) return false;
        int wgid = (int)L; { const int q = nwg / NXCD, r = nwg % NXCD, xcd = wgid % NXCD, off = wgid / NXCD; wgid = (xcd < r ? xcd * (q + 1) : r * (q + 1) + (xcd - r) * q) + off; }
        const int nig = WGM * nN, gid = wgid / nig, fm = gid * WGM, gsz = (nM - fm) < WGM ? (nM - fm) : WGM;
        u.pm = fm + ((wgid % nig) % gsz); u.pn = (wgid % nig) / gsz; return true;
    }
    __device__ __forceinline__ void a_ready(const Unit&) const {}
    __device__ __forceinline__ void done(const Unit&) const {}
};

__device__ __forceinline__ unsigned cvt_pk_bf16(float lo, float hi) { unsigned r; asm volatile("v_cvt_pk_bf16_f32 %0, %1, %2" : "=v"(r) : "v"(lo), "v"(hi)); return r; }

__device__ __forceinline__ float silu_mul(float g, float u) { return g * __builtin_amdgcn_rcpf(1.0f + __builtin_amdgcn_exp2f(-1.4426950408889634f * g)) * u; }

struct EpiSwiGLU {
    static constexpr bool PERM = true, AFTER_DRAIN = false;
    bf16_t* O; int ldc;
    __device__ __forceinline__ void operator()(const f32x4 (&acc)[2][2][4][2], const Unit& u, int wr, int wc, int fr, int fq) const {
        const int row0 = u.pm * BM + wr * 64 + fr, col0 = u.pn * HALF + wc * 32 + 8 * fq;
#pragma unroll
        for (int ai = 0; ai < 2; ++ai)
#pragma unroll
            for (int m = 0; m < 4; ++m) { bf16_t* rowp = O + (size_t)(row0 + ai * HALF + m * 16) * ldc + col0;
                const f32x4 g0 = acc[ai][0][m][0], g1 = acc[ai][0][m][1], u0 = acc[ai][1][m][0], u1 = acc[ai][1][m][1];
                u32x4 w; w.x = cvt_pk_bf16(silu_mul(g0[0], u0[0]), silu_mul(g0[1], u0[1])); w.y = cvt_pk_bf16(silu_mul(g0[2], u0[2]), silu_mul(g0[3], u0[3]));
                w.z = cvt_pk_bf16(silu_mul(g1[0], u1[0]), silu_mul(g1[1], u1[1])); w.w = cvt_pk_bf16(silu_mul(g1[2], u1[2]), silu_mul(g1[3], u1[3]));
                *(u32x4*)rowp = w; }
    }
};
struct EpiBf16G {
    static constexpr bool PERM = true, AFTER_DRAIN = false;
    bf16_t* O; int ldc, bjstride; const float* bias; const float* scale;
    __device__ __forceinline__ void operator()(const f32x4 (&acc)[2][2][4][2], const Unit& u, int wr, int wc, int fr, int fq) const {
        const int row0 = u.pm * BM + wr * 64 + fr, cc = wc * 32 + 8 * fq;
        f32x4 bv[2][2], sv[2][2];
#pragma unroll
        for (int bj = 0; bj < 2; ++bj)
#pragma unroll
            for (int n = 0; n < 2; ++n) { const int c = u.pn * BM + bj * HALF + cc + 4 * n;
                bv[bj][n] = bias ? *(const f32x4*)(bias + c) : (f32x4){0.f, 0.f, 0.f, 0.f}; sv[bj][n] = scale ? *(const f32x4*)(scale + c) : (f32x4){1.f, 1.f, 1.f, 1.f}; }
#pragma unroll
        for (int ai = 0; ai < 2; ++ai)
#pragma unroll
            for (int m = 0; m < 4; ++m) { bf16_t* rowp = O + (size_t)(row0 + ai * HALF + m * 16) * ldc + cc;
#pragma unroll
                for (int bj = 0; bj < 2; ++bj) { const f32x4 v0 = (acc[ai][bj][m][0] + bv[bj][0]) * sv[bj][0], v1 = (acc[ai][bj][m][1] + bv[bj][1]) * sv[bj][1];
                    u32x4 w; w.x = cvt_pk_bf16(v0[0], v0[1]); w.y = cvt_pk_bf16(v0[2], v0[3]); w.z = cvt_pk_bf16(v1[0], v1[1]); w.w = cvt_pk_bf16(v1[2], v1[3]);
                    *(u32x4*)(rowp + (size_t)(u.pn * 2 + bj) * bjstride) = w; } }
    }
};
struct EpiF32 {
    static constexpr bool PERM = false, AFTER_DRAIN = false;
    float* C; int ldc;
    __device__ __forceinline__ void operator()(const f32x4 (&acc)[2][2][4][2], const Unit& u, int wr, int wc, int fr, int fq) const {
        const int row0 = u.pm * BM + wr * 64 + fr, col0 = u.pn * BM + wc * 32 + 4 * fq;
#pragma unroll
        for (int ai = 0; ai < 2; ++ai)
#pragma unroll
            for (int m = 0; m < 4; ++m) { float* rowp = C + (size_t)(row0 + ai * HALF + m * 16) * ldc + col0;
#pragma unroll
                for (int bj = 0; bj < 2; ++bj)
#pragma unroll
                    for (int n = 0; n < 2; ++n) *(f32x4*)(rowp + bj * HALF + n * 16) = acc[ai][bj][m][n]; }
    }
};
struct EpiQ {
    static constexpr bool PERM = true, AFTER_DRAIN = false;
    bf16_t* O; const float* cosT; const float* sinT; float qscale;
    __device__ __forceinline__ void operator()(const f32x4 (&acc)[2][2][4][2], const Unit& u, int wr, int wc, int fr, int fq) const {
        const int row0 = u.pm * BM + wr * 64 + fr;
#pragma unroll
        for (int bj = 0; bj < 2; ++bj) {
            const int c0 = u.pn * BM + bj * HALF + wc * 32 + 8 * fq; const int hd = c0 / 192, d = c0 - hd * 192; const bool rope = d >= 128; const int i0 = rope ? ((d - 128) >> 1) : 0;
#pragma unroll
            for (int ai = 0; ai < 2; ++ai)
#pragma unroll
                for (int m = 0; m < 4; ++m) { const int row = row0 + ai * HALF + m * 16;
                    f32x4 v0 = acc[ai][bj][m][0], v1 = acc[ai][bj][m][1];
                    if (rope) { const f32x4 cs = *(const f32x4*)(cosT + (size_t)row * 32 + i0), sn = *(const f32x4*)(sinT + (size_t)row * 32 + i0);
                        const f32x4 a = v0, b = v1;
                        v0[0] = a[0] * cs[0] - a[1] * sn[0]; v0[1] = a[1] * cs[0] + a[0] * sn[0]; v0[2] = a[2] * cs[1] - a[3] * sn[1]; v0[3] = a[3] * cs[1] + a[2] * sn[1];
                        v1[0] = b[0] * cs[2] - b[1] * sn[2]; v1[1] = b[1] * cs[2] + b[0] * sn[2]; v1[2] = b[2] * cs[3] - b[3] * sn[3]; v1[3] = b[3] * cs[3] + b[2] * sn[3]; }
                    v0 = v0 * qscale; v1 = v1 * qscale;
                    u32x4 w; w.x = cvt_pk_bf16(v0[0], v0[1]); w.y = cvt_pk_bf16(v0[2], v0[3]); w.z = cvt_pk_bf16(v1[0], v1[1]); w.w = cvt_pk_bf16(v1[2], v1[3]);
                    *(u32x4*)(O + (size_t)row * 3072 + c0) = w; }
        }
    }
};

template <class Epi, class Sched, bool ALIGN_EPI = false, bool SP2 = false>
__device__ __forceinline__ void gemm_phase(PG8_LAS unsigned char* lds, const Gemm g, const Sched& S, const Epi& E, const int tid) {
    const int wid = __builtin_amdgcn_readfirstlane(tid >> 6), lane = tid & 63, wr = wid >> 2, wc = wid & 3, fr = lane & 15, fq = lane >> 4;
    const int K = g.K, nt = K / BK;
    unsigned voffA[2], voffB[2];
#pragma unroll
    for (int i = 0; i < 2; ++i) { int R, C; stage_rc(tid * 16 + i * 8192, R, C); const int Rb = Epi::PERM ? ((R & ~31) + perm32(R & 31)) : R;
        voffA[i] = (unsigned)(R * g.lda + C) * 2u; voffB[i] = (unsigned)(Rb * g.ldb + C) * 2u; }
    const size_t kstep = (size_t)(BK * 2);
    const size_t hsA = (size_t)HALF * g.lda * 2, hsB = (size_t)HALF * g.ldb * 2;
    const unsigned ldsw = (unsigned)wid * 1024u;
    const int aoff = lds_byte(wr * 64 + fr, fq * 8), boff = lds_byte(wc * 32 + fr, fq * 8);
#define PG8_SA(b, h) (((b) * 2 + (h)) * HTB)
#define PG8_SB(b, h) ((4 + (b) * 2 + (h)) * HTB)
#define PG8_STAGE(bufoff, gbase, voff) do { _Pragma("unroll") for (int _i = 0; _i < 2; ++_i) \
        __builtin_amdgcn_global_load_lds((const unsigned*)((const char*)(gbase) + (voff)[_i]), (PG8_LAS unsigned*)(lds + (bufoff) + ldsw + _i * 8192), 16, 0, 0); } while (0)
#define PG8_LDA(dst, b, h) do { _Pragma("unroll") for (int m = 0; m < 4; ++m) _Pragma("unroll") for (int k = 0; k < 2; ++k) dst[m][k] = *(const PG8_LAS bf16x8*)(lds + PG8_SA(b, h) + aoff + m * 2048 + k * 1024); } while (0)
#define PG8_LDB(dst, b, h) do { _Pragma("unroll") for (int n = 0; n < 2; ++n) _Pragma("unroll") for (int k = 0; k < 2; ++k) dst[n][k] = *(const PG8_LAS bf16x8*)(lds + PG8_SB(b, h) + boff + n * 2048 + k * 1024); } while (0)
#define PG8_MMA(ai, bj, At, Bt) do { __builtin_amdgcn_s_setprio(1); _Pragma("unroll") for (int m = 0; m < 4; ++m) _Pragma("unroll") for (int n = 0; n < 2; ++n) _Pragma("unroll") for (int k = 0; k < 2; ++k) \
        acc[ai][bj][m][n] = __builtin_amdgcn_mfma_f32_16x16x32_bf16(Bt[n][k], At[m][k], acc[ai][bj][m][n], 0, 0, 0); __builtin_amdgcn_s_setprio(0); } while (0)
#define PG8_WAIT_V(n) asm volatile("s_waitcnt vmcnt(" #n ")" ::: "memory")
#define PG8_WAIT_L(n) asm volatile("s_waitcnt lgkmcnt(" #n ")" ::: "memory")
#define PG8_BAR __builtin_amdgcn_s_barrier()
#define PG8_SCHED __builtin_amdgcn_sched_barrier(0)
    Unit cur, nxt; int ui = 0;
    if (!S.next(0, cur)) return;
    f32x4 acc[2][2][4][2];
#pragma unroll
    for (int a = 0; a < 2; ++a)
#pragma unroll
        for (int b = 0; b < 2; ++b)
#pragma unroll
            for (int m = 0; m < 4; ++m)
#pragma unroll
                for (int n = 0; n < 2; ++n) acc[a][b][m][n] = (f32x4){0.f, 0.f, 0.f, 0.f};
    bf16x8 At[4][2], B0[2][2], B1[2][2];
    const char* cA = (const char*)g.A + (size_t)cur.pm * 2 * hsA + (size_t)((cur.pn >> g.ashift) * g.astep) * 2; const char* cB = (const char*)g.Bt + (size_t)cur.pn * 2 * hsB;
    S.a_ready(cur);
    if constexpr (SP2) {
        PG8_STAGE(PG8_SB(0, 0), cB, voffB); PG8_STAGE(PG8_SB(0, 1), cB + hsB, voffB); PG8_STAGE(PG8_SA(0, 0), cA, voffA); PG8_STAGE(PG8_SA(0, 1), cA + hsA, voffA);
        if (wr == 1) PG8_BAR;
        PG8_WAIT_V(2); PG8_BAR;
        PG8_STAGE(PG8_SB(1, 0), cB + kstep, voffB); PG8_STAGE(PG8_SA(1, 0), cA + kstep, voffA); PG8_STAGE(PG8_SB(1, 1), cB + hsB + kstep, voffB);
        PG8_WAIT_V(6); PG8_BAR;
    } else {
        PG8_STAGE(PG8_SB(0, 0), cB, voffB); PG8_STAGE(PG8_SA(0, 0), cA, voffA); PG8_STAGE(PG8_SB(0, 1), cB + hsB, voffB); PG8_STAGE(PG8_SA(0, 1), cA + hsA, voffA);
        if (wr == 1) PG8_BAR;
        PG8_WAIT_V(4); PG8_BAR;
        PG8_STAGE(PG8_SB(1, 0), cB + kstep, voffB); PG8_STAGE(PG8_SA(1, 0), cA + kstep, voffA); PG8_STAGE(PG8_SB(1, 1), cB + hsB + kstep, voffB);
        PG8_WAIT_V(6); PG8_BAR;
    }
    for (;;) {
        const bool has_next = S.next(ui + 1, nxt);
        const char* nA = has_next ? (const char*)g.A + (size_t)nxt.pm * 2 * hsA + (size_t)((nxt.pn >> g.ashift) * g.astep) * 2 : cA; const char* nB = has_next ? (const char*)g.Bt + (size_t)nxt.pn * 2 * hsB : cB;
        for (int t = 0; t < nt; t += 2) {
            const bool last = (t == nt - 2);
            const char* a1 = cA + (size_t)(t + 1) * kstep;
            const char* a2 = last ? nA : cA + (size_t)(t + 2) * kstep; const char* b2 = last ? nB : cB + (size_t)(t + 2) * kstep;
            const char* a3 = a2 + kstep; const char* b3 = b2 + kstep;
            if (last && has_next) S.a_ready(nxt);
            if constexpr (SP2) {
            PG8_LDB(B0, 0, 0); PG8_LDB(B1, 0, 1); PG8_SCHED; PG8_LDA(At, 0, 0); PG8_STAGE(PG8_SA(1, 1), a1 + hsA, voffA);
            PG8_WAIT_V(8); PG8_WAIT_L(0); PG8_BAR; PG8_MMA(0, 0, At, B0); PG8_MMA(0, 1, At, B1); PG8_BAR; PG8_SCHED;
            PG8_LDA(At, 0, 1); PG8_STAGE(PG8_SB(0, 0), b2, voffB); PG8_STAGE(PG8_SB(0, 1), b2 + hsB, voffB); PG8_STAGE(PG8_SA(0, 0), a2, voffA);
            PG8_WAIT_V(8); PG8_WAIT_L(0); PG8_BAR; PG8_MMA(1, 0, At, B0); PG8_MMA(1, 1, At, B1); PG8_BAR; PG8_SCHED;
            PG8_LDB(B0, 1, 0); PG8_LDB(B1, 1, 1); PG8_SCHED; PG8_LDA(At, 1, 0); PG8_STAGE(PG8_SA(0, 1), a2 + hsA, voffA);
            PG8_WAIT_V(8); PG8_WAIT_L(0); PG8_BAR; PG8_MMA(0, 0, At, B0); PG8_MMA(0, 1, At, B1); PG8_BAR; PG8_SCHED;
            PG8_LDA(At, 1, 1); PG8_STAGE(PG8_SB(1, 0), b3, voffB); PG8_STAGE(PG8_SB(1, 1), b3 + hsB, voffB); PG8_STAGE(PG8_SA(1, 0), a3, voffA);
            PG8_WAIT_V(8); PG8_WAIT_L(0); PG8_BAR; PG8_MMA(1, 0, At, B0); PG8_MMA(1, 1, At, B1); PG8_BAR; PG8_SCHED;
            } else {
            PG8_LDB(B0, 0, 0); PG8_SCHED; PG8_LDA(At, 0, 0); PG8_STAGE(PG8_SA(1, 1), a1 + hsA, voffA);
            PG8_WAIT_L(8); PG8_BAR; PG8_WAIT_L(0); PG8_MMA(0, 0, At, B0); PG8_BAR; PG8_SCHED;
            PG8_LDB(B1, 0, 1); PG8_STAGE(PG8_SB(0, 0), b2, voffB);
            PG8_BAR; PG8_WAIT_L(0); PG8_MMA(0, 1, At, B1); PG8_BAR;
            PG8_LDA(At, 0, 1); PG8_STAGE(PG8_SA(0, 0), a2, voffA);
            PG8_BAR; PG8_WAIT_L(0); PG8_MMA(1, 0, At, B0); PG8_BAR; PG8_SCHED;
            PG8_STAGE(PG8_SB(0, 1), b2 + hsB, voffB);
            PG8_WAIT_V(6); PG8_BAR; PG8_MMA(1, 1, At, B1); PG8_BAR;
            PG8_LDB(B0, 1, 0); PG8_SCHED; PG8_LDA(At, 1, 0); PG8_STAGE(PG8_SA(0, 1), a2 + hsA, voffA);
            PG8_WAIT_L(8); PG8_BAR; PG8_WAIT_L(0); PG8_MMA(0, 0, At, B0); PG8_BAR; PG8_SCHED;
            PG8_LDB(B1, 1, 1); PG8_STAGE(PG8_SB(1, 0), b3, voffB);
            PG8_BAR; PG8_WAIT_L(0); PG8_MMA(0, 1, At, B1); PG8_BAR;
            PG8_LDA(At, 1, 1); PG8_STAGE(PG8_SA(1, 0), a3, voffA);
            PG8_BAR; PG8_WAIT_L(0); PG8_MMA(1, 0, At, B0); PG8_BAR; PG8_SCHED;
            PG8_STAGE(PG8_SB(1, 1), b3 + hsB, voffB);
            PG8_WAIT_V(6); PG8_BAR; PG8_MMA(1, 1, At, B1); PG8_BAR;
            }
        }
        if constexpr (ALIGN_EPI) { if (wr == 0) PG8_BAR; }
        E(acc, cur, wr, wc, fr, fq); S.done(cur);
        if (!has_next) break;
#pragma unroll
        for (int a = 0; a < 2; ++a)
#pragma unroll
            for (int b = 0; b < 2; ++b)
#pragma unroll
                for (int m = 0; m < 4; ++m)
#pragma unroll
                    for (int n = 0; n < 2; ++n) acc[a][b][m][n] = (f32x4){0.f, 0.f, 0.f, 0.f};
        cur = nxt; cA = nA; cB = nB; ++ui;
        if constexpr (ALIGN_EPI) { if (wr == 1) PG8_BAR; }
    }
    PG8_WAIT_V(0);
    if constexpr (!ALIGN_EPI) { if (wr == 0) PG8_BAR; }
    PG8_BAR;
#undef PG8_SA
#undef PG8_SB
#undef PG8_STAGE
#undef PG8_LDA
#undef PG8_LDB
#undef PG8_MMA
#undef PG8_WAIT_V
#undef PG8_WAIT_L
#undef PG8_BAR
#undef PG8_SCHED
}
}

constexpr int NWAVES = 8;
constexpr int BATCH = 4, SEQ = 4096, D = 2048, M = BATCH * SEQ, DFF = 5632, NMODJ = 18432, DEPTH = 4;
constexpr int NH = 16, QLR = 512, KVLR = 512, DN = 128, DR = 64, DV = 128, DQK = 192;
constexpr int NQA = 1280;
constexpr int NQ = NH * DQK;
constexpr float EPS = 1e-6f;
constexpr float QSCALE = 0.07216878364870322f * 1.4426950408889634f;

constexpr size_t MiB = 1u << 20;
constexpr size_t WS_CTL = 0, CTL_ZERO_BYTES = 1 * MiB;
constexpr size_t WS_MOD = 1 * MiB;
constexpr size_t WS_COS = 3 * MiB, WS_SIN = 5 * MiB;
constexpr size_t WS_WGU = 8 * MiB;
constexpr size_t WS_WD = 360 * MiB;
constexpr size_t WS_WPOOL = 536 * MiB;
constexpr size_t WS_WQA = 540 * MiB;
constexpr size_t WS_WUQ = 550 * MiB;
constexpr size_t WS_WUKV = 556 * MiB;
constexpr size_t WS_WO = 564 * MiB;
constexpr size_t WS_H = 580 * MiB;
constexpr size_t WS_HF = 644 * MiB;
constexpr size_t WS_ACT = 772 * MiB;
constexpr size_t WS_F = 948 * MiB;
constexpr size_t WS_POOLED = 1012 * MiB;
constexpr size_t WS_QA = 1076 * MiB;
constexpr size_t WS_CQ = 1156 * MiB;
constexpr size_t WS_CKV = 1172 * MiB;
constexpr size_t WS_Q = 1188 * MiB;
constexpr size_t WS_K = 1284 * MiB;
constexpr size_t WS_VT = 1380 * MiB;
constexpr size_t WS_O = 1444 * MiB;
constexpr size_t WS_END = 1508 * MiB;
constexpr int CW_BAR = 4096;

constexpr int RING_OFF = 0, RING_BYTES = 131072;
constexpr int LDSCTL_OFF = RING_BYTES, MISC_OFF = LDSCTL_OFF + 320;
constexpr int LDS_BYTES = 147456;

#define GAS __attribute__((address_space(1)))
#define LAS __attribute__((address_space(3)))
typedef unsigned short bf16;
typedef unsigned v4u __attribute__((ext_vector_type(4)));
typedef unsigned v2u __attribute__((ext_vector_type(2)));
typedef float f32x4 __attribute__((ext_vector_type(4)));
typedef float f32x16 __attribute__((ext_vector_type(16)));
typedef short bf16x8 __attribute__((ext_vector_type(8)));
typedef short s16x4 __attribute__((ext_vector_type(4)));
typedef GAS unsigned gu32;
#define LDS_WAIT() asm volatile("s_waitcnt lgkmcnt(0)" ::: "memory")
__device__ __forceinline__ unsigned f2bf(float f) { unsigned u = __builtin_bit_cast(unsigned, f); return (u + 0x7fffu + ((u >> 16) & 1u)) >> 16; }
__device__ __forceinline__ unsigned pk2(float lo, float hi) { return f2bf(lo) | (f2bf(hi) << 16); }
__device__ __forceinline__ float bflo(unsigned w) { return __builtin_bit_cast(float, w << 16); }
__device__ __forceinline__ float bfhi(unsigned w) { return __builtin_bit_cast(float, w & 0xffff0000u); }

#define XB_TMO      128
#define XB_XCNT(j)  (256  + 64 * (j))
#define XB_XSUB(j)  (1280 + 64 * (j))
#define XB_XGEN(j)  (2304 + 64 * (j))
#define XB_TOP      3328
#define XB_TOPGEN   3392
#define XCD_BAR_WORDS 3456
#define XB_SPIN_CAP (1u << 18)

__device__ __forceinline__ unsigned xb_ld(unsigned* p)              { return __hip_atomic_load(p, __ATOMIC_RELAXED, __HIP_MEMORY_SCOPE_AGENT); }
__device__ __forceinline__ unsigned xb_add(unsigned* p, unsigned v) { return __hip_atomic_fetch_add(p, v, __ATOMIC_RELAXED, __HIP_MEMORY_SCOPE_AGENT); }
__device__ __forceinline__ unsigned xb_xcc_id() { return (unsigned)__builtin_amdgcn_s_getreg((3 << 11) | 20) & 0xFu; }
#define XB_SPIN(cond, bar) do { unsigned _sp = 0; while (cond) { __builtin_amdgcn_s_sleep(1); \
    if ((++_sp & 255u) == 0u) { if (xb_ld(&(bar)[XB_TMO])) break; if (_sp > XB_SPIN_CAP) { atomicAdd(&(bar)[XB_TMO], 1u); break; } } } } while (0)

struct XcdBarrier { unsigned* bar; unsigned x; volatile LAS unsigned* st; };

__device__ __forceinline__ XcdBarrier xcd_barrier_post(unsigned* bar, volatile LAS unsigned* st) {
    XcdBarrier b; b.bar = bar; b.x = xb_xcc_id(); b.st = st;
    if (threadIdx.x == 0) (void)xb_add(&bar[XB_XCNT(b.x)], 1u);
    return b;
}
__device__ __forceinline__ void xcd_barrier_complete(unsigned* bar, unsigned x, unsigned& nloc, unsigned& nx) {
    const unsigned G = gridDim.x * gridDim.y * gridDim.z;
    unsigned sum, cnt, mine, sp = 0u;
    for (;;) {
        sum = 0u; cnt = 0u; mine = 0u;
#pragma unroll
        for (unsigned j = 0; j < 16; ++j) { const unsigned c = xb_ld(&bar[XB_XCNT(j)]); sum += c; cnt += (c > 0u) ? 1u : 0u; mine = (j == x) ? c : mine; }
        if (sum == G) break;
        __builtin_amdgcn_s_sleep(1);
        if ((++sp & 255u) == 0u) { if (xb_ld(&bar[XB_TMO])) break; if (sp > XB_SPIN_CAP) { atomicAdd(&bar[XB_TMO], 1u); break; } }
    }
    nloc = mine > 0u ? mine : 1u; nx = cnt > 0u ? cnt : 1u;
}
__device__ __forceinline__ void xcd_barrier(const XcdBarrier& b) {
    asm volatile("s_waitcnt vmcnt(0)" ::: "memory");
    __syncthreads();
    if (threadIdx.x == 0) {
        unsigned* bar = b.bar;
        __builtin_amdgcn_s_waitcnt(0);
        unsigned nloc = b.st[0], nx = b.st[1];
        if (nloc == 0u) { xcd_barrier_complete(bar, b.x, nloc, nx); b.st[0] = nloc; b.st[1] = nx; }
        const unsigned old = xb_add(&bar[XB_XSUB(b.x)], 1u);
        const unsigned gen = old / nloc;
        if (old + 1u == (gen + 1u) * nloc) {
            __builtin_amdgcn_fence(__ATOMIC_RELEASE, "agent");
            asm volatile("s_waitcnt vmcnt(0)" ::: "memory");
            const unsigned og = xb_add(&bar[XB_TOP], 1u);
            const unsigned tg = og / nx;
            if (og + 1u == (tg + 1u) * nx) xb_add(&bar[XB_TOPGEN], 1u);
            else XB_SPIN(xb_ld(&bar[XB_TOPGEN]) == tg, bar);
            __builtin_amdgcn_fence(__ATOMIC_ACQUIRE, "agent");
            xb_add(&bar[XB_XGEN(b.x)], 1u);
            asm volatile("s_waitcnt vmcnt(0)" ::: "memory");
        } else {
            XB_SPIN(xb_ld(&bar[XB_XGEN(b.x)]) == gen, bar);
            __builtin_amdgcn_fence(__ATOMIC_ACQUIRE, "agent");
            asm volatile("s_waitcnt vmcnt(0)" ::: "memory");
        }
    }
    __syncthreads();
}

typedef const void* cvp_t;
#define CAS __attribute__((address_space(4)))
struct Frame {
    LAS unsigned char* lds;
    int tid, lane, wave, vcu, G;
    const CAS cvp_t* kin;
    float* out; unsigned char* ws;
};
__device__ __forceinline__ const float* ldarg(const CAS cvp_t* kin, int i) { asm volatile("" : "+s"(kin)); return (const float*)kin[i]; }
#define F_x          ldarg(F.kin, 0)
#define F_c          ldarg(F.kin, 1)
#define F_pos        ((const int*)ldarg(F.kin, 2))
#define F_ada_w      ldarg(F.kin, 3)
#define F_ada_b      ldarg(F.kin, 4)
#define F_norm_pre   ldarg(F.kin, 5)
#define F_norm_post  ldarg(F.kin, 6)
#define F_w_gate     ldarg(F.kin, 7)
#define F_w_up       ldarg(F.kin, 8)
#define F_w_down     ldarg(F.kin, 9)
#define F_pool_w     ldarg(F.kin, 10)
#define F_pool_b     ldarg(F.kin, 11)
#define F_pool_scale ldarg(F.kin, 12)
#define F_w_dq       ldarg(F.kin, 13)
#define F_q_norm     ldarg(F.kin, 14)
#define F_w_uq       ldarg(F.kin, 15)
#define F_w_dkv      ldarg(F.kin, 16)
#define F_kv_norm    ldarg(F.kin, 17)
#define F_w_ukv      ldarg(F.kin, 18)
#define F_w_o        ldarg(F.kin, 19)
__device__ __forceinline__ float wave_sum(float v) {
#pragma unroll
    for (int o = 1; o < 64; o <<= 1) v += __shfl_xor(v, o);
    return v;
}

enum { MAP_ID = 0, MAP_GATE = 1, MAP_UP = 2, MAP_DKV = 3, MAP_UQ = 4, MAP_UKV = 5 };
__device__ __forceinline__ int map_row(int kind, int n, int off) {
    switch (kind) {
        case MAP_GATE: return ((n >> 7) << 8) + (n & 127);
        case MAP_UP:   return ((n >> 7) << 8) + 128 + (n & 127);
        case MAP_DKV:  { if (n < 512) return 512 + n; const int j = n - 512; return 1024 + 2 * (j & 31) + (j >> 5); }
        case MAP_UQ:   { const int h = n / 192, d = n - h * 192; if (d < 128) return n; const int j = d - 128; return h * 192 + 128 + 2 * (j & 31) + (j >> 5); }
        case MAP_UKV:  { const int h = n >> 8, d = n & 255; return d < 128 ? h * 128 + d : 2048 + h * 128 + (d - 128); }
        default:       return off + n;
    }
}
__device__ __forceinline__ void tr_item(const float* W, int K, int N, bf16* WT, int kind, int off, LAS float* scr, int item, int lane) {
    const int nblk = N / 32, kb = item / nblk, nb = item % nblk, k0 = 64 * kb, n0 = 32 * nb;
#pragma unroll 8
    for (int i = 0; i < 32; ++i) { const int kk = 2 * i + (lane >> 5); scr[kk * 33 + (lane & 31)] = W[(size_t)(k0 + kk) * N + n0 + (lane & 31)]; }
    LDS_WAIT(); asm volatile("" ::: "memory");
    const int c = lane & 7;
#pragma unroll
    for (int j = 0; j < 4; ++j) { const int n = (lane >> 3) + 8 * j; const LAS float* s = scr + (8 * c) * 33 + n;
        v4u o; o.x = pk2(s[0 * 33], s[1 * 33]); o.y = pk2(s[2 * 33], s[3 * 33]); o.z = pk2(s[4 * 33], s[5 * 33]); o.w = pk2(s[6 * 33], s[7 * 33]);
        *(GAS v4u*)(WT + (size_t)map_row(kind, n0 + n, off) * K + k0 + 8 * c) = o; }
    LDS_WAIT(); asm volatile("" ::: "memory");
}

constexpr int NIT_FFN = 8 * 3 * 5632, NIT_POOL = 2 * 4 * 128, NIT_MLA1 = 512 + 576 + 768 + 1024 + 2048, NIT_ALL = NIT_FFN + NIT_POOL + 2 * NIT_MLA1;

__device__ __forceinline__ void p0_prologue(Frame& F) {
    {
        LAS float* cact = (LAS float*)(F.lds + RING_OFF);
        LAS float* red = (LAS float*)(F.lds + RING_OFF + 32768);
        for (int i = F.tid; i < 4 * D; i += NWAVES * 64) { const int b = i / D, k = i % D; const float v = F_c[i]; cact[k * 4 + b] = v / (1.0f + __expf(-v)); }
        __syncthreads();
        float* mod = (float*)(F.ws + WS_MOD);
        for (int it = blockIdx.x; it < 4 * (NMODJ / 64); it += F.G) {
            const int l = it / (NMODJ / 64), j0 = (it % (NMODJ / 64)) * 64;
            const float* wp = F_ada_w + ((size_t)l * D + F.wave * 256) * NMODJ + j0 + F.lane;
            float a0 = 0.f, a1 = 0.f, a2 = 0.f, a3 = 0.f;
#pragma unroll 16
            for (int kk = 0; kk < 256; ++kk) { const float w = wp[(size_t)kk * NMODJ]; const f32x4 ca = *(const LAS f32x4*)(cact + (F.wave * 256 + kk) * 4);
                a0 += ca[0] * w; a1 += ca[1] * w; a2 += ca[2] * w; a3 += ca[3] * w; }
            red[(F.wave * 4 + 0) * 64 + F.lane] = a0; red[(F.wave * 4 + 1) * 64 + F.lane] = a1; red[(F.wave * 4 + 2) * 64 + F.lane] = a2; red[(F.wave * 4 + 3) * 64 + F.lane] = a3;
            __syncthreads();
            if (F.tid < 256) { const int b = F.tid >> 6, ln = F.tid & 63; float s = 0.f;
#pragma unroll
                for (int w = 0; w < 8; ++w) s += red[(w * 4 + b) * 64 + ln];
                mod[((size_t)l * 4 + b) * NMODJ + j0 + ln] = s + F_ada_b[(size_t)l * NMODJ + j0 + ln]; }
            __syncthreads();
        }
    }
    {
        float* cosT = (float*)(F.ws + WS_COS); float* sinT = (float*)(F.ws + WS_SIN);
        for (int i = blockIdx.x * (NWAVES * 64) + F.tid; i < M * 32; i += F.G * NWAVES * 64) {
            const int row = i >> 5, fi = i & 31;
            const float inv_freq = exp2f(-(float)(2 * fi) * (1.0f / 64.0f) * 13.287712379549449f);
            const float ang = (float)F_pos[row] * inv_freq;
            double t = (double)ang * 0.15915494309189535; t -= floor(t);
            const float tf = (float)t;
            cosT[i] = __builtin_amdgcn_cosf(tf); sinT[i] = __builtin_amdgcn_sinf(tf);
        }
    }
    {
        for (int ml = 0; ml < 2; ++ml) { v4u* p = (v4u*)(F.ws + WS_WQA + (size_t)ml * NQA * D * 2 + (size_t)1088 * D * 2); const int n16 = (NQA - 1088) * D * 2 / 16;
            for (int i = blockIdx.x * (NWAVES * 64) + F.tid; i < n16; i += F.G * NWAVES * 64) p[i] = (v4u){0u, 0u, 0u, 0u}; }
    }
    {
        LAS float* scr = (LAS float*)(F.lds + RING_OFF + F.wave * 16384);
        const int gw = blockIdx.x * NWAVES + F.wave, NGW = F.G * NWAVES;
        for (int it = gw; it < NIT_ALL; it += NGW) {
            if (it < NIT_FFN) { const int lf = it / 16896, r = it % 16896, kind = r / 5632, sub = r % 5632;
                if (kind == 0) tr_item(F_w_gate + (size_t)lf * D * DFF, D, DFF, (bf16*)(F.ws + WS_WGU) + (size_t)lf * 2 * DFF * D, MAP_GATE, 0, scr, sub, F.lane);
                else if (kind == 1) tr_item(F_w_up + (size_t)lf * D * DFF, D, DFF, (bf16*)(F.ws + WS_WGU) + (size_t)lf * 2 * DFF * D, MAP_UP, 0, scr, sub, F.lane);
                else tr_item(F_w_down + (size_t)lf * DFF * D, DFF, D, (bf16*)(F.ws + WS_WD) + (size_t)lf * D * DFF, MAP_ID, 0, scr, sub, F.lane);
            } else if (it < NIT_FFN + NIT_POOL) { const int r = it - NIT_FFN, pl = r / 512, g = (r % 512) / 128, sub = r % 128;
                tr_item(F_pool_w + (size_t)(pl * 4 + g) * 512 * 512, 512, 512, (bf16*)(F.ws + WS_WPOOL) + (size_t)pl * D * 512, MAP_ID, g * 512, scr, sub, F.lane);
            } else { int r = it - NIT_FFN - NIT_POOL; const int ml = r / NIT_MLA1; r %= NIT_MLA1;
                if (r < 512) tr_item(F_w_dq + (size_t)ml * D * QLR, D, QLR, (bf16*)(F.ws + WS_WQA) + (size_t)ml * NQA * D, MAP_ID, 0, scr, r, F.lane);
                else if (r < 1088) tr_item(F_w_dkv + (size_t)ml * D * 576, D, 576, (bf16*)(F.ws + WS_WQA) + (size_t)ml * NQA * D, MAP_DKV, 0, scr, r - 512, F.lane);
                else if (r < 1856) tr_item(F_w_uq + (size_t)ml * QLR * NQ, QLR, NQ, (bf16*)(F.ws + WS_WUQ) + (size_t)ml * NQ * QLR, MAP_UQ, 0, scr, r - 1088, F.lane);
                else if (r < 2880) tr_item(F_w_ukv + (size_t)ml * KVLR * 4096, KVLR, 4096, (bf16*)(F.ws + WS_WUKV) + (size_t)ml * 4096 * KVLR, MAP_UKV, 0, scr, r - 1856, F.lane);
                else tr_item(F_w_o + (size_t)ml * D * D, D, D, (bf16*)(F.ws + WS_WO) + (size_t)ml * D * D, MAP_ID, 0, scr, r - 2880, F.lane);
            }
        }
    }
}

__device__ __forceinline__ void norm_phase(Frame& F, const float* xsrc, float* xdst, const bf16* fin, const float* gpost, const float* modpost  , float wgt,
                                           const float* gpre, const float* modpre, bf16* hb, float* hf) {
    LAS float* V1 = (LAS float*)(F.lds + RING_OFF); LAS float* V2 = V1 + D; LAS float* V3 = V2 + D;
    const bool has_post = fin != nullptr, has_pre = gpre != nullptr;
    for (int chunk = blockIdx.x; chunk < M / 64; chunk += F.G) {
        const int r0 = chunk * 64, b = r0 / SEQ, c4 = F.tid * 4;
        {
            f32x4 a1 = {0.f, 0.f, 0.f, 0.f}, a2 = a1, a3 = a1;
            if (has_post) { const f32x4 gp = *(const f32x4*)(gpost + c4), gt = *(const f32x4*)(modpost + (size_t)b * NMODJ + 2 * D + c4); a1 = wgt * gp * (1.0f + gt); }
            if (has_pre) { const f32x4 gp = *(const f32x4*)(gpre + c4), sc = *(const f32x4*)(modpre + (size_t)b * NMODJ + D + c4); a2 = gp * (1.0f + sc); a3 = *(const f32x4*)(modpre + (size_t)b * NMODJ + c4); }
            *(LAS f32x4*)(V1 + c4) = a1; *(LAS f32x4*)(V2 + c4) = a2; *(LAS f32x4*)(V3 + c4) = a3;
        }
        __syncthreads();
#pragma unroll 1
        for (int i = 0; i < 8; ++i) {
            const int row = r0 + F.wave * 8 + i; const size_t ro = (size_t)row * D + 4 * F.lane;
            f32x4 xv[8];
#pragma unroll
            for (int j = 0; j < 8; ++j) xv[j] = *(const f32x4*)(xsrc + ro + 256 * j);
            if (has_post) {
                v2u fv[8]; float ss = 0.f;
#pragma unroll
                for (int j = 0; j < 8; ++j) { fv[j] = *(const v2u*)(fin + ro + 256 * j); const float f0 = bflo(fv[j].x), f1 = bfhi(fv[j].x), f2 = bflo(fv[j].y), f3 = bfhi(fv[j].y); ss += (f0 * f0 + f1 * f1) + (f2 * f2 + f3 * f3); }
                const float rstd = 1.0f / sqrtf(wave_sum(ss) * (1.0f / D) + EPS);
#pragma unroll
                for (int j = 0; j < 8; ++j) { const f32x4 a1 = *(const LAS f32x4*)(V1 + 4 * F.lane + 256 * j); const f32x4 fvv = {bflo(fv[j].x), bfhi(fv[j].x), bflo(fv[j].y), bfhi(fv[j].y)};
                    xv[j] = xv[j] + a1 * (fvv * rstd); *(f32x4*)(xdst + ro + 256 * j) = xv[j]; }
            }
            if (has_pre) {
                float ss = 0.f;
#pragma unroll
                for (int j = 0; j < 8; ++j) ss += (xv[j].x * xv[j].x + xv[j].y * xv[j].y) + (xv[j].z * xv[j].z + xv[j].w * xv[j].w);
                const float rstd = 1.0f / sqrtf(wave_sum(ss) * (1.0f / D) + EPS);
#pragma unroll
                for (int j = 0; j < 8; ++j) { const f32x4 a2 = *(const LAS f32x4*)(V2 + 4 * F.lane + 256 * j), a3 = *(const LAS f32x4*)(V3 + 4 * F.lane + 256 * j);
                    const f32x4 hv = xv[j] * rstd * a2 + a3;
                    if (hf) *(f32x4*)(hf + ro + 256 * j) = hv;
                    else { v2u o; o.x = pk2(hv.x, hv.y); o.y = pk2(hv.z, hv.w); *(v2u*)(hb + ro + 256 * j) = o; } }
            }
        }
        __syncthreads();
    }
}

__device__ __forceinline__ void pool_window_phase(Frame& F, const float* hf, bf16* pooled) {
    const int gw = blockIdx.x * NWAVES + F.wave, NGW = F.G * NWAVES;
    for (int blk = gw; blk < M / 8; blk += NGW) {
        const int t0 = blk * 8, ts0 = t0 % SEQ;
#pragma unroll 1
        for (int j = 0; j < 8; ++j) {
            const int w = 2 << (j >> 1); const size_t co = 4 * F.lane + 256 * j;
            f32x4 S = {0.f, 0.f, 0.f, 0.f};
            const int lo = ts0 - w > 0 ? ts0 - w : 0;
            for (int ti = lo; ti < ts0; ++ti) S = S + *(const f32x4*)(hf + (size_t)(t0 - ts0 + ti) * D + co);
#pragma unroll 1
            for (int r = 0; r < 8; ++r) {
                const int t = ts0 + r; const f32x4 hv = *(const f32x4*)(hf + (size_t)(t0 + r) * D + co);
                S = S + hv;
                if (t - w >= 0) S = S - *(const f32x4*)(hf + (size_t)(t0 + r - w) * D + co);
                const float inv = 1.0f / (float)(t + 1 < w ? t + 1 : w);
                const f32x4 pv = S * inv - hv;
                v2u o; o.x = pk2(pv.x, pv.y); o.y = pk2(pv.z, pv.w); *(v2u*)(pooled + (size_t)(t0 + r) * D + co) = o;
            }
        }
    }
}

__device__ __forceinline__ void mla_mid_phase(Frame& F, const float* QA, const float* qn, const float* kvn, bf16* cq, bf16* ckv, bf16* Kb) {
    const int gw = blockIdx.x * NWAVES + F.wave, NGW = F.G * NWAVES;
    const float* cosT = (const float*)(F.ws + WS_COS); const float* sinT = (const float*)(F.ws + WS_SIN);
    const f32x4 qn0 = *(const f32x4*)(qn + 8 * F.lane), qn1 = *(const f32x4*)(qn + 8 * F.lane + 4), kn0 = *(const f32x4*)(kvn + 8 * F.lane), kn1 = *(const f32x4*)(kvn + 8 * F.lane + 4);
    for (int row = gw; row < M; row += NGW) {
        const float* qa = QA + (size_t)row * NQA;
        { f32x4 v0 = *(const f32x4*)(qa + 8 * F.lane), v1 = *(const f32x4*)(qa + 8 * F.lane + 4);
          const float ss = (v0.x * v0.x + v0.y * v0.y) + (v0.z * v0.z + v0.w * v0.w) + (v1.x * v1.x + v1.y * v1.y) + (v1.z * v1.z + v1.w * v1.w);
          const float rstd = 1.0f / sqrtf(wave_sum(ss) * (1.0f / 512.0f) + EPS); v0 = v0 * rstd * qn0; v1 = v1 * rstd * qn1;
          v4u o; o.x = pk2(v0.x, v0.y); o.y = pk2(v0.z, v0.w); o.z = pk2(v1.x, v1.y); o.w = pk2(v1.z, v1.w); *(v4u*)(cq + (size_t)row * 512 + 8 * F.lane) = o; }
        { f32x4 v0 = *(const f32x4*)(qa + 512 + 8 * F.lane), v1 = *(const f32x4*)(qa + 512 + 8 * F.lane + 4);
          const float ss = (v0.x * v0.x + v0.y * v0.y) + (v0.z * v0.z + v0.w * v0.w) + (v1.x * v1.x + v1.y * v1.y) + (v1.z * v1.z + v1.w * v1.w);
          const float rstd = 1.0f / sqrtf(wave_sum(ss) * (1.0f / 512.0f) + EPS); v0 = v0 * rstd * kn0; v1 = v1 * rstd * kn1;
          v4u o; o.x = pk2(v0.x, v0.y); o.y = pk2(v0.z, v0.w); o.z = pk2(v1.x, v1.y); o.w = pk2(v1.z, v1.w); *(v4u*)(ckv + (size_t)row * 512 + 8 * F.lane) = o; }
        if (F.lane < 32) { const float x1 = qa[1024 + 2 * F.lane], x2 = qa[1024 + 2 * F.lane + 1], cs = cosT[(size_t)row * 32 + F.lane], sn = sinT[(size_t)row * 32 + F.lane];
            const unsigned o = pk2(x1 * cs - x2 * sn, x2 * cs + x1 * sn); unsigned* kp = (unsigned*)(Kb + (size_t)row * NQ + 128 + 2 * F.lane);
#pragma unroll
            for (int h = 0; h < NH; ++h) kp[h * (DQK / 2)] = o; }
    }
}

namespace att {
constexpr int KSTR = 400, VSTR = 136, KBUF = 64 * KSTR, VBUF = 128 * VSTR, BUF = KBUF + VBUF;
static_assert(2 * BUF <= RING_BYTES, "attention LDS");
__device__ __forceinline__ int crow(int r, int hi) { return (r & 3) + 8 * (r >> 2) + 4 * hi; }
__device__ __forceinline__ void unit(LAS unsigned char* lds, const bf16* Q, const bf16* Kg, const bf16* VT, bf16* O, int b, int h, int qb, int tid, int wave, int lane) {
    const int q0 = b * SEQ + qb * 256, ntiles = 4 * (qb + 1), l31 = lane & 31, hi = lane >> 5;
    bf16x8 qf[12];
    { const bf16* qp = Q + (size_t)(q0 + 32 * wave + l31) * NQ + h * DQK + 8 * hi;
#pragma unroll
      for (int ks = 0; ks < 12; ++ks) qf[ks] = *(const bf16x8*)(qp + 16 * ks); }
    f32x16 o[4];
#pragma unroll
    for (int db = 0; db < 4; ++db)
#pragma unroll
        for (int r = 0; r < 16; ++r) o[db][r] = 0.f;
    float mrun = -1e30f, lrun = 0.f;
    const bf16* kbase = Kg + (size_t)(b * SEQ) * NQ + h * DQK;
    const bf16* vbase = VT + (size_t)(h * DV) * M + b * SEQ;
    const int kgo = (tid >> 3) * NQ + (tid & 7) * 8, klo = (tid >> 3) * KSTR + (tid & 7) * 16;
    const int vgo = (tid >> 2) * M + (tid & 3) * 8, vlo = KBUF + (tid >> 2) * VSTR + (tid & 3) * 16;
    v4u kr[3], vr[2];
#define ATT_LOAD(jt) do { const bf16* kp_ = kbase + (size_t)(jt) * 64 * NQ + kgo; const bf16* vp_ = vbase + (jt) * 64 + vgo; \
                          _Pragma("unroll") for (int i = 0; i < 3; ++i) kr[i] = *(const v4u*)(kp_ + 64 * i); \
                          _Pragma("unroll") for (int i = 0; i < 2; ++i) vr[i] = *(const v4u*)(vp_ + 32 * i); } while (0)
#define ATT_WRITE(bufo) do { _Pragma("unroll") for (int i = 0; i < 3; ++i) *(LAS v4u*)(lds + (bufo) + klo + 128 * i) = kr[i]; \
                             _Pragma("unroll") for (int i = 0; i < 2; ++i) { *(LAS v2u*)(lds + (bufo) + vlo + 64 * i) = (v2u){vr[i].x, vr[i].y}; *(LAS v2u*)(lds + (bufo) + vlo + 64 * i + 8) = (v2u){vr[i].z, vr[i].w}; } } while (0)
    ATT_LOAD(0); ATT_WRITE(0);
    __syncthreads();
    const int qrel = 32 * wave + l31;
#pragma unroll 1
    for (int jt = 0; jt < ntiles; ++jt) {
        const bool more = jt + 1 < ntiles;
        if (more) ATT_LOAD(jt + 1);
        const int cur = (jt & 1) * BUF;
        const int krel0 = 64 * (jt - 4 * qb);
        if (krel0 <= 32 * wave + 31) {
            f32x16 p0, p1;
#pragma unroll
            for (int r = 0; r < 16; ++r) { p0[r] = 0.f; p1[r] = 0.f; }
            const LAS unsigned char* kb = lds + cur + l31 * KSTR + hi * 16;
#pragma unroll
            for (int ks = 0; ks < 12; ++ks) { const bf16x8 a0 = *(const LAS bf16x8*)(kb + ks * 32), a1 = *(const LAS bf16x8*)(kb + 32 * KSTR + ks * 32);
                p0 = __builtin_amdgcn_mfma_f32_32x32x16_bf16(a0, qf[ks], p0, 0, 0, 0); p1 = __builtin_amdgcn_mfma_f32_32x32x16_bf16(a1, qf[ks], p1, 0, 0, 0); }
            if (krel0 + 63 > 32 * wave) {
                const float NEG = -__builtin_inff();
#pragma unroll
                for (int r = 0; r < 16; ++r) { const int kk = krel0 + crow(r, hi); if (kk > qrel) p0[r] = NEG; if (kk + 32 > qrel) p1[r] = NEG; }
            }
            float mx = p0[0];
#pragma unroll
            for (int r = 1; r < 16; ++r) mx = fmaxf(mx, p0[r]);
#pragma unroll
            for (int r = 0; r < 16; ++r) mx = fmaxf(mx, p1[r]);
            mx = fmaxf(mx, __shfl_xor(mx, 32));
            const float mn = fmaxf(mrun, mx), alpha = __builtin_amdgcn_exp2f(mrun - mn); mrun = mn;
            float ps = 0.f;
#pragma unroll
            for (int r = 0; r < 16; ++r) { p0[r] = __builtin_amdgcn_exp2f(p0[r] - mn); p1[r] = __builtin_amdgcn_exp2f(p1[r] - mn); ps += p0[r] + p1[r]; }
            ps += __shfl_xor(ps, 32);
            lrun = lrun * alpha + ps;
#pragma unroll
            for (int db = 0; db < 4; ++db)
#pragma unroll
                for (int r = 0; r < 16; ++r) o[db][r] *= alpha;
            bf16x8 pf[2][2];
#pragma unroll
            for (int s = 0; s < 2; ++s) {
                v4u w0, w1;
                w0.x = pg8::cvt_pk_bf16(p0[8 * s + 0], p0[8 * s + 1]); w0.y = pg8::cvt_pk_bf16(p0[8 * s + 2], p0[8 * s + 3]); w0.z = pg8::cvt_pk_bf16(p0[8 * s + 4], p0[8 * s + 5]); w0.w = pg8::cvt_pk_bf16(p0[8 * s + 6], p0[8 * s + 7]);
                w1.x = pg8::cvt_pk_bf16(p1[8 * s + 0], p1[8 * s + 1]); w1.y = pg8::cvt_pk_bf16(p1[8 * s + 2], p1[8 * s + 3]); w1.z = pg8::cvt_pk_bf16(p1[8 * s + 4], p1[8 * s + 5]); w1.w = pg8::cvt_pk_bf16(p1[8 * s + 6], p1[8 * s + 7]);
                pf[0][s] = __builtin_bit_cast(bf16x8, w0); pf[1][s] = __builtin_bit_cast(bf16x8, w1);
            }
            const LAS unsigned char* vb = lds + cur + KBUF + l31 * VSTR + hi * 8;
#pragma unroll
            for (int db = 0; db < 4; ++db)
#pragma unroll
                for (int kb2 = 0; kb2 < 2; ++kb2)
#pragma unroll
                    for (int s = 0; s < 2; ++s) { const LAS unsigned char* ap = vb + db * 32 * VSTR + (32 * kb2 + 16 * s) * 2;
                        const v2u lo = *(const LAS v2u*)ap, hi4 = *(const LAS v2u*)(ap + 16);
                        const v4u av = {lo.x, lo.y, hi4.x, hi4.y};
                        o[db] = __builtin_amdgcn_mfma_f32_32x32x16_bf16(__builtin_bit_cast(bf16x8, av), pf[kb2][s], o[db], 0, 0, 0); }
        }
        if (more) ATT_WRITE(((jt + 1) & 1) * BUF);
        __syncthreads();
    }
#undef ATT_LOAD
#undef ATT_WRITE
    const float inv = 1.0f / lrun;
    bf16* op = O + (size_t)(q0 + qrel) * D + h * DV + 4 * hi;
#pragma unroll
    for (int db = 0; db < 4; ++db)
#pragma unroll
        for (int g = 0; g < 4; ++g) { v2u w; w.x = pg8::cvt_pk_bf16(o[db][4 * g] * inv, o[db][4 * g + 1] * inv); w.y = pg8::cvt_pk_bf16(o[db][4 * g + 2] * inv, o[db][4 * g + 3] * inv);
            *(v2u*)(op + 32 * db + 8 * g) = w; }
}
__device__ __forceinline__ void phase(Frame& F, const bf16* Q, const bf16* Kg, const bf16* VT, bf16* O) {
    for (int it = F.vcu; it < BATCH * NH * 8; it += F.G) {
        const int bh = it >> 3, s = it & 7, b = bh / NH, h = bh % NH;
        unit(F.lds + RING_OFF, Q, Kg, VT, O, b, h, 15 - s, F.tid, F.wave, F.lane);
        unit(F.lds + RING_OFF, Q, Kg, VT, O, b, h, s, F.tid, F.wave, F.lane);
    }
}
}

struct Args { const void* in[20]; float* out; unsigned char* ws; int ph_lo, ph_hi; };
constexpr int N_PHASES = 2 + DEPTH * 6 + 2 * 3 + 2 * 6;

__device__ __forceinline__ const float* modp(const Frame& F, int layer, int sub) { return (const float*)(F.ws + WS_MOD) + (size_t)layer * 4 * NMODJ + (size_t)sub * 3 * D; }

#define GRID_BAR() xcd_barrier(bar)
#define PH_BEGIN if (ph >= lo && ph < hi) { { int t_ = threadIdx.x; asm volatile("" : "+v"(t_)); F.tid = t_; F.lane = t_ & 63; F.wave = __builtin_amdgcn_readfirstlane(t_ >> 6); }
#define PH_END   if (ph + 1 < hi) GRID_BAR(); } ++ph;

#define FFN_SUBLAYER(layer, fidx, sub, xsrc_, nl, ns, hf_) do { \
    const int lf_ = (layer) * 2 + (fidx); \
    PH_BEGIN { pg8::Gemm g{(const bf16*)(F.ws + WS_H), (const bf16*)(F.ws + WS_WGU) + (size_t)lf_ * 2 * DFF * D, M, 2 * DFF, D, D, D, 0, 0}; pg8::StaticOrder S; S.init(M, 2 * DFF, F.G, (int)blockIdx.x); \
        pg8::EpiSwiGLU E{(bf16*)(F.ws + WS_ACT), DFF}; pg8::gemm_phase<pg8::EpiSwiGLU, pg8::StaticOrder, true, true>(F.lds + RING_OFF, g, S, E, F.tid); } PH_END \
    PH_BEGIN { pg8::Gemm g{(const bf16*)(F.ws + WS_ACT), (const bf16*)(F.ws + WS_WD) + (size_t)lf_ * D * DFF, M, D, DFF, DFF, DFF, 0, 0}; pg8::StaticOrder S; S.init(M, D, F.G, (int)blockIdx.x); \
        pg8::EpiBf16G E{(bf16*)(F.ws + WS_F), D, 128, nullptr, nullptr}; pg8::gemm_phase<pg8::EpiBf16G, pg8::StaticOrder, true, true>(F.lds + RING_OFF, g, S, E, F.tid); } PH_END \
    PH_BEGIN { const bool hn_ = (nl) < DEPTH; \
        norm_phase(F, (xsrc_), F.out, (const bf16*)(F.ws + WS_F), F_norm_post + ((size_t)(layer) * 3 + (sub)) * D, modp(F, (layer), (sub)), 0.5f, \
                   hn_ ? F_norm_pre + ((size_t)(nl) * 3 + (ns)) * D : nullptr, hn_ ? modp(F, (nl), (ns)) : nullptr, (bf16*)(F.ws + WS_H), (hf_) ? (float*)(F.ws + WS_HF) : nullptr); } PH_END \
} while (0)

__global__ void __launch_bounds__(NWAVES * 64, 2) mk_fwd(Args args) {
    extern __shared__ __attribute__((aligned(16))) unsigned char lds[];
    Frame F;
    F.lds = (LAS unsigned char*)lds;
    F.tid = threadIdx.x; F.lane = F.tid & 63; F.wave = __builtin_amdgcn_readfirstlane(F.tid >> 6);
    F.G = gridDim.x; { const int bx = blockIdx.x; F.vcu = (F.G % 8 == 0) ? (bx % 8) * (F.G / 8) + bx / 8 : bx; }
    F.kin = (const CAS cvp_t*)__builtin_amdgcn_kernarg_segment_ptr();
    F.out = args.out; F.ws = args.ws;
    for (int u = F.tid; u < (LDS_BYTES - LDSCTL_OFF) / 4; u += NWAVES * 64) ((LAS unsigned*)(F.lds + LDSCTL_OFF))[u] = 0u;
    __syncthreads();
    XcdBarrier bar = xcd_barrier_post((unsigned*)(F.ws + WS_CTL) + CW_BAR, (volatile LAS unsigned*)(F.lds + MISC_OFF) + 8);
    const int lo = args.ph_lo, hi = args.ph_hi;
    int ph = 0;

    PH_BEGIN {
#ifndef NO_P0
 p0_prologue(F);
#endif
 } PH_END
    PH_BEGIN { norm_phase(F, F_x, F.out, nullptr, nullptr, nullptr, 0.f, F_norm_pre, modp(F, 0, 0), (bf16*)(F.ws + WS_H), nullptr); } PH_END

#pragma unroll 1
    for (int lp = 0; lp < NLP; ++lp) {
        const int l0 = 2 * lp, l1 = 2 * lp + 1;
        FFN_SUBLAYER(l0, 0, 0, (lp == 0 ? F_x : (const float*)F.out), l0, 1, true);
        PH_BEGIN { pool_window_phase(F, (const float*)(F.ws + WS_HF), (bf16*)(F.ws + WS_POOLED)); } PH_END
        PH_BEGIN { pg8::Gemm g{(const bf16*)(F.ws + WS_POOLED), (const bf16*)(F.ws + WS_WPOOL) + (size_t)lp * D * 512, M, D, 512, D, 512, 1, 512}; pg8::StaticOrder S; S.init(M, D, F.G, (int)blockIdx.x);
            pg8::EpiBf16G E{(bf16*)(F.ws + WS_F), D, 128, F_pool_b + (size_t)lp * D, F_pool_scale + (size_t)lp * D}; pg8::gemm_phase<pg8::EpiBf16G, pg8::StaticOrder, true, true>(F.lds + RING_OFF, g, S, E, F.tid); } PH_END
        PH_BEGIN { norm_phase(F, F.out, F.out, (const bf16*)(F.ws + WS_F), F_norm_post + ((size_t)l0 * 3 + 1) * D, modp(F, l0, 1), 1.0f, F_norm_pre + ((size_t)l0 * 3 + 2) * D, modp(F, l0, 2), (bf16*)(F.ws + WS_H), nullptr); } PH_END
        FFN_SUBLAYER(l0, 1, 2, (const float*)F.out, l1, 0, false);
        FFN_SUBLAYER(l1, 0, 0, (const float*)F.out, l1, 1, false);
        PH_BEGIN { pg8::Gemm g{(const bf16*)(F.ws + WS_H), (const bf16*)(F.ws + WS_WQA) + (size_t)lp * NQA * D, M, NQA, D, D, D, 0, 0}; pg8::StaticOrder S; S.init(M, NQA, F.G, (int)blockIdx.x);
            pg8::EpiF32 E{(float*)(F.ws + WS_QA), NQA}; pg8::gemm_phase<pg8::EpiF32, pg8::StaticOrder, true, true>(F.lds + RING_OFF, g, S, E, F.tid); } PH_END
        PH_BEGIN { mla_mid_phase(F, (const float*)(F.ws + WS_QA), F_q_norm + (size_t)lp * QLR, F_kv_norm + (size_t)lp * KVLR, (bf16*)(F.ws + WS_CQ), (bf16*)(F.ws + WS_CKV), (bf16*)(F.ws + WS_K)); } PH_END
        PH_BEGIN {
            { pg8::Gemm g{(const bf16*)(F.ws + WS_CQ), (const bf16*)(F.ws + WS_WUQ) + (size_t)lp * NQ * QLR, M, NQ, QLR, QLR, QLR, 0, 0}; pg8::StaticOrder S; S.init(M, NQ, F.G, (int)blockIdx.x);
              pg8::EpiQ E{(bf16*)(F.ws + WS_Q), (const float*)(F.ws + WS_COS), (const float*)(F.ws + WS_SIN), QSCALE}; pg8::gemm_phase<pg8::EpiQ, pg8::StaticOrder, true, true>(F.lds + RING_OFF, g, S, E, F.tid); }
            { pg8::Gemm g{(const bf16*)(F.ws + WS_CKV), (const bf16*)(F.ws + WS_WUKV) + (size_t)lp * 4096 * KVLR, M, D, KVLR, KVLR, KVLR, 0, 0}; pg8::StaticOrder S; S.init(M, D, F.G, (int)blockIdx.x);
              pg8::EpiBf16G E{(bf16*)(F.ws + WS_K), NQ, DQK, nullptr, nullptr}; pg8::gemm_phase<pg8::EpiBf16G, pg8::StaticOrder, true, true>(F.lds + RING_OFF, g, S, E, F.tid); }
            { pg8::Gemm g{(const bf16*)(F.ws + WS_WUKV) + (size_t)lp * 4096 * KVLR + (size_t)2048 * KVLR, (const bf16*)(F.ws + WS_CKV), D, M, KVLR, KVLR, KVLR, 0, 0}; pg8::StaticOrder S; S.init(D, M, F.G, (int)blockIdx.x);
              pg8::EpiBf16G E{(bf16*)(F.ws + WS_VT), M, 128, nullptr, nullptr}; pg8::gemm_phase<pg8::EpiBf16G, pg8::StaticOrder, true, true>(F.lds + RING_OFF, g, S, E, F.tid); }
        } PH_END
        PH_BEGIN {
#ifndef NO_ATT
 att::phase(F, (const bf16*)(F.ws + WS_Q), (const bf16*)(F.ws + WS_K), (const bf16*)(F.ws + WS_VT), (bf16*)(F.ws + WS_O));
#endif
 } PH_END
        PH_BEGIN { pg8::Gemm g{(const bf16*)(F.ws + WS_O), (const bf16*)(F.ws + WS_WO) + (size_t)lp * D * D, M, D, D, D, D, 0, 0}; pg8::StaticOrder S; S.init(M, D, F.G, (int)blockIdx.x);
            pg8::EpiBf16G E{(bf16*)(F.ws + WS_F), D, 128, nullptr, nullptr}; pg8::gemm_phase<pg8::EpiBf16G, pg8::StaticOrder, true, true>(F.lds + RING_OFF, g, S, E, F.tid); } PH_END
        PH_BEGIN { norm_phase(F, F.out, F.out, (const bf16*)(F.ws + WS_F), F_norm_post + ((size_t)l1 * 3 + 1) * D, modp(F, l1, 1), 1.0f, F_norm_pre + ((size_t)l1 * 3 + 2) * D, modp(F, l1, 2), (bf16*)(F.ws + WS_H), nullptr); } PH_END
        FFN_SUBLAYER(l1, 1, 2, (const float*)F.out, l1 + 1, 0, false);
    }
}

extern "C" void kernel_launch(void* const* d_in, const int* in_sizes, int n_in, void* d_out, int out_size, void* d_ws, size_t ws_size, hipStream_t stream) {
    static int grid = 0;
    if (grid == 0) {
        if (n_in != 20 || in_sizes[0] != M * D || out_size != M * D || ws_size < WS_END) { fprintf(stderr, "kernel_launch: unexpected shapes (n_in %d, in0 %d, out %d, ws %zu); nothing launched\n", n_in, n_in > 0 ? in_sizes[0] : -1, out_size, ws_size); grid = -1; return; }
        int dev = 0, cus = 0, per_cu = 0;
        if (hipGetDevice(&dev) != hipSuccess || hipDeviceGetAttribute(&cus, hipDeviceAttributeMultiprocessorCount, dev) != hipSuccess) { fprintf(stderr, "kernel_launch: device query failed\n"); grid = -1; return; }
        if (hipFuncSetAttribute((const void*)mk_fwd, hipFuncAttributeMaxDynamicSharedMemorySize, LDS_BYTES) != hipSuccess) { fprintf(stderr, "kernel_launch: hipFuncSetAttribute failed\n"); grid = -1; return; }
        if (hipOccupancyMaxActiveBlocksPerMultiprocessor(&per_cu, (const void*)mk_fwd, NWAVES * 64, LDS_BYTES) != hipSuccess || per_cu < 1)
            fprintf(stderr, "kernel_launch: note: occupancy query reports %d workgroups per CU\n", per_cu);
        (void)hipGetLastError();
        grid = cus;
    }
    if (grid < 0) return;
    if (hipMemsetAsync((char*)d_ws + WS_CTL, 0, CTL_ZERO_BYTES, stream) != hipSuccess) { fprintf(stderr, "kernel_launch: memset failed\n"); return; }
    Args a{};
    for (int i = 0; i < 20; ++i) a.in[i] = d_in[i];
    a.out = (float*)d_out; a.ws = (unsigned char*)d_ws;
#if MK_ONE_LAUNCH
    a.ph_lo = 0; a.ph_hi = N_PHASES;
    hipLaunchKernelGGL(mk_fwd, dim3(grid), dim3(NWAVES * 64), LDS_BYTES, stream, a);
#else
    for (int p = 0; p < N_PHASES; ++p) { a.ph_lo = p; a.ph_hi = p + 1; hipLaunchKernelGGL(mk_fwd, dim3(grid), dim3(NWAVES * 64), LDS_BYTES, stream, a); }
#endif
    const hipError_t le = hipPeekAtLastError();
    if (le != hipSuccess) fprintf(stderr, "kernel_launch: launch failed: %s\n", hipGetErrorName(le));
}
```
